# Optimizing an MI355X kernel written in HIP

```python
import math
import jax, jax.numpy as jnp
from jax import lax
import numpy as np

D_MODEL = 1024
BATCH = 4
SEQ = 4096
DEPTH = 1

CHUNK = 64
Q_BLOCK = 128
EPS = 1e-6
MLA_HEADS = 8
MLA_NOPE = 64
MLA_ROPE = 32
MLA_QK = MLA_NOPE + MLA_ROPE
MLA_V = 64
MLA_Q_LORA = 384
MLA_KV_LORA = 256
ROPE_THETA = 10000.0
DIFF_HEADS = 4
DIFF_HEAD_DIM = 64
DIFF_V = 2 * DIFF_HEAD_DIM
REL_BUCKETS = 32
REL_MAX_DIST = 128
MIX_WIDTH = MLA_HEADS * MLA_V + DIFF_HEADS * DIFF_V
IN_WIDTHS = (MLA_Q_LORA, MLA_KV_LORA, MLA_ROPE,
             DIFF_HEADS * 2 * DIFF_HEAD_DIM, DIFF_HEADS * 2 * DIFF_HEAD_DIM, DIFF_HEADS * DIFF_V)
IN_WIDTH = sum(IN_WIDTHS)
IN_SPLITS = np.cumsum(IN_WIDTHS)[:-1].tolist()
N_GROUPS = 4
EXPERTS_PER_GROUP = 4
N_EXPERTS = N_GROUPS * EXPERTS_PER_GROUP
TOP_K = 2
D_EXPERT = 512

kernel_name = "hymba_mla_diffattn_hmoe_adaln"


def _rms(x, g):
    xf = x.astype(jnp.float32)
    y = xf * lax.rsqrt(jnp.mean(xf * xf, axis=-1, keepdims=True) + EPS)
    return (y * g.astype(jnp.float32)).astype(x.dtype)


def _to_blocks(a):
    b, s = a.shape[0], a.shape[1]
    return jnp.moveaxis(a.reshape(b, s // Q_BLOCK, Q_BLOCK, *a.shape[2:]), 1, 0)


def _from_blocks(a):
    a = jnp.moveaxis(a, 0, 1)
    return a.reshape(a.shape[0], a.shape[1] * a.shape[2], *a.shape[3:])


def _rope(x, cos, sin):
    x1, x2 = jnp.split(x, 2, axis=-1)
    return jnp.concatenate([x1 * cos - x2 * sin, x2 * cos + x1 * sin], axis=-1)


def _rel_bucket(rel):
    nb = REL_BUCKETS // 2
    max_exact = nb // 2
    n = jnp.abs(rel)
    large = max_exact + (jnp.log(jnp.maximum(n, 1).astype(jnp.float32) / max_exact)
                         / math.log(REL_MAX_DIST / max_exact) * (nb - max_exact)).astype(jnp.int32)
    large = jnp.minimum(large, nb - 1)
    return jnp.where(rel > 0, nb, 0) + jnp.where(n < max_exact, n, large)


def _mla(c_q, c_kv, k_pe, positions, cq_g, w_uq, ckv_g, w_ukv, q_g, k_g):
    B, S, _ = c_q.shape
    q = (_rms(c_q, cq_g) @ w_uq).reshape(B, S, MLA_HEADS, MLA_QK)
    kv = (_rms(c_kv, ckv_g) @ w_ukv).reshape(B, S, MLA_HEADS, MLA_NOPE + MLA_V)
    k_nope, v = kv[..., :MLA_NOPE], kv[..., MLA_NOPE:]
    k = jnp.concatenate([k_nope, jnp.broadcast_to(k_pe[:, :, None, :], (B, S, MLA_HEADS, MLA_ROPE))], axis=-1)
    q, k = _rms(q, q_g), _rms(k, k_g)
    inv_freq = ROPE_THETA ** (-jnp.arange(0, MLA_ROPE // 2, dtype=jnp.float32) / (MLA_ROPE // 2))
    ang = positions.astype(jnp.float32)[..., None] * inv_freq
    cos = jnp.cos(ang)[:, :, None, :].astype(q.dtype)
    sin = jnp.sin(ang)[:, :, None, :].astype(q.dtype)
    q = jnp.concatenate([q[..., :MLA_NOPE], _rope(q[..., MLA_NOPE:], cos, sin)], axis=-1)
    k = jnp.concatenate([k[..., :MLA_NOPE], _rope(k[..., MLA_NOPE:], cos, sin)], axis=-1)
    scale = MLA_QK ** -0.5
    key_chunk = jnp.arange(S) // CHUNK
    q_chunks = key_chunk.reshape(S // Q_BLOCK, Q_BLOCK)

    def block(args):
        qb, qc = args
        s = jnp.einsum('bqhd,bkhd->bhqk', qb, k).astype(jnp.float32) * scale
        s = jnp.where(key_chunk[None, :] <= qc[:, None], s, -jnp.inf)
        p = jax.nn.softmax(s, axis=-1).astype(v.dtype)
        return jnp.einsum('bhqk,bkhe->bqhe', p, v)

    o = _from_blocks(lax.map(block, (_to_blocks(q), q_chunks)))
    return o.reshape(B, S, MLA_HEADS * MLA_V)


def _diff_attn(dq, dk, dv, positions, rel_bias, q_g, k_g, lq1, lk1, lq2, lk2, subln_g, lambda_init):
    B, S, _ = dq.shape
    q = _rms(dq.reshape(B, S, DIFF_HEADS, 2, DIFF_HEAD_DIM), q_g)
    k = _rms(dk.reshape(B, S, DIFF_HEADS, 2, DIFF_HEAD_DIM), k_g)
    v = dv.reshape(B, S, DIFF_HEADS, DIFF_V)
    lam = (jnp.exp(jnp.sum(lq1.astype(jnp.float32) * lk1.astype(jnp.float32)))
           - jnp.exp(jnp.sum(lq2.astype(jnp.float32) * lk2.astype(jnp.float32))) + lambda_init)
    scale = DIFF_HEAD_DIM ** -0.5
    key_chunk = jnp.arange(S) // CHUNK
    q_chunks = key_chunk.reshape(S // Q_BLOCK, Q_BLOCK)

    def block(args):
        qb, qpos, qc = args
        s = jnp.einsum('bqhmd,bkhmd->bhmqk', qb, k).astype(jnp.float32) * scale
        bucket = _rel_bucket(positions[:, None, :] - qpos[:, :, None])
        bias = jnp.moveaxis(rel_bias[bucket], -1, 1).astype(jnp.float32)
        s = jnp.where(key_chunk[None, :] <= qc[:, None], s + bias[:, :, None], -jnp.inf)
        p = jax.nn.softmax(s, axis=-1)
        a = (p[:, :, 0] - lam * p[:, :, 1]).astype(v.dtype)
        return jnp.einsum('bhqk,bkhe->bqhe', a, v)

    o = _from_blocks(lax.map(block, (_to_blocks(q), _to_blocks(positions), q_chunks)))
    o = _rms(o, subln_g) * (1.0 - lambda_init)
    return o.reshape(B, S, DIFF_HEADS * DIFF_V)


def _hmoe(h, w_rg, b_rg, w_re, b_re, w_gate, w_up, w_down):
    B, S, D = h.shape
    t = h.reshape(B * S, D)
    g_logits = (t @ w_rg + b_rg).astype(jnp.float32)
    g_idx = jnp.argmax(g_logits, axis=-1)
    g_w = jnp.take_along_axis(jax.nn.softmax(g_logits, axis=-1), g_idx[:, None], axis=-1)
    e_logits = (t @ w_re + b_re).astype(jnp.float32).reshape(-1, N_GROUPS, EXPERTS_PER_GROUP)
    e_sel = jnp.take_along_axis(e_logits, g_idx[:, None, None], axis=1)[:, 0]
    top_v, top_i = lax.top_k(e_sel, TOP_K)
    top_w = jax.nn.softmax(top_v, axis=-1) * g_w
    gate_in = jnp.sum(jax.nn.one_hot(top_i, EXPERTS_PER_GROUP, dtype=jnp.float32) * top_w[..., None], axis=1)
    gate = (jax.nn.one_hot(g_idx, N_GROUPS, dtype=jnp.float32)[:, :, None]
            * gate_in[:, None, :]).reshape(-1, N_EXPERTS).astype(h.dtype)
    y = jnp.zeros_like(t)
    for e in range(N_EXPERTS):
        he = jax.nn.silu(t @ w_gate[e]) * (t @ w_up[e])
        y = y + gate[:, e:e + 1] * (he @ w_down[e])
    return y.reshape(B, S, D)


def setup_inputs(seed: int = 0) -> dict:
    key = jax.random.key(seed)
    ks = jax.random.split(key, 40)
    D, L, f32 = D_MODEL, DEPTH, jnp.float32

    def nrm(k, shape, fan_in, mult=1.0):
        return jax.random.normal(k, shape, f32) * (mult * fan_in ** -0.5)

    def gain(k, shape):
        return 1.0 + 0.05 * jax.random.normal(k, shape, f32)

    def small(k, shape, s):
        return s * jax.random.normal(k, shape, f32)

    offs = jax.random.randint(ks[2], (BATCH, 1), 0, 1024, dtype=jnp.int32)
    return {
        "x": jax.random.normal(ks[0], (BATCH, SEQ, D), f32),
        "c": jax.random.normal(ks[1], (BATCH, D), f32),
        "positions": (offs + jnp.arange(SEQ, dtype=jnp.int32)[None, :]).astype(jnp.int32),
        "rel_bias": small(ks[3], (REL_BUCKETS, DIFF_HEADS), 0.5),
        "w_ada": nrm(ks[4], (L, D, 6 * D), D, 0.5),
        "b_ada": small(ks[5], (L, 6 * D), 0.02),
        "norm1_g": gain(ks[6], (L, D)),
        "w_in": nrm(ks[7], (L, D, IN_WIDTH), D),
        "mla_cq_g": gain(ks[8], (L, MLA_Q_LORA)),
        "w_uq": nrm(ks[9], (L, MLA_Q_LORA, MLA_HEADS * MLA_QK), MLA_Q_LORA),
        "mla_ckv_g": gain(ks[10], (L, MLA_KV_LORA)),
        "w_ukv": nrm(ks[11], (L, MLA_KV_LORA, MLA_HEADS * (MLA_NOPE + MLA_V)), MLA_KV_LORA),
        "mla_q_g": gain(ks[12], (L, MLA_QK)),
        "mla_k_g": gain(ks[13], (L, MLA_QK)),
        "diff_q_g": gain(ks[14], (L, DIFF_HEAD_DIM)),
        "diff_k_g": gain(ks[15], (L, DIFF_HEAD_DIM)),
        "lambda_q1": small(ks[16], (L, DIFF_HEAD_DIM), 0.1),
        "lambda_k1": small(ks[17], (L, DIFF_HEAD_DIM), 0.1),
        "lambda_q2": small(ks[18], (L, DIFF_HEAD_DIM), 0.1),
        "lambda_k2": small(ks[19], (L, DIFF_HEAD_DIM), 0.1),
        "diff_subln_g": gain(ks[20], (L, DIFF_V)),
        "w_o": nrm(ks[21], (L, MIX_WIDTH, D), MIX_WIDTH),
        "norm2_g": gain(ks[22], (L, D)),
        "w_rg": nrm(ks[23], (L, D, N_GROUPS), D),
        "b_rg": small(ks[24], (L, N_GROUPS), 0.01),
        "w_re": nrm(ks[25], (L, D, N_EXPERTS), D),
        "b_re": small(ks[26], (L, N_EXPERTS), 0.01),
        "w_gate": nrm(ks[27], (L, N_EXPERTS, D, D_EXPERT), D),
        "w_up": nrm(ks[28], (L, N_EXPERTS, D, D_EXPERT), D),
        "w_down": nrm(ks[29], (L, N_EXPERTS, D_EXPERT, D), D_EXPERT),
    }


def reference(x, c, positions, rel_bias, w_ada, b_ada, norm1_g, w_in, mla_cq_g, w_uq, mla_ckv_g, w_ukv,
              mla_q_g, mla_k_g, diff_q_g, diff_k_g, lambda_q1, lambda_k1, lambda_q2, lambda_k2,
              diff_subln_g, w_o, norm2_g, w_rg, b_rg, w_re, b_re, w_gate, w_up, w_down):
    for l in range(DEPTH):
        lambda_init = 0.8 - 0.6 * math.exp(-0.3 * l)
        mod = jnp.einsum('bd,de->be', jax.nn.silu(c), w_ada[l]) + b_ada[l]
        sh1, sc1, g1, sh2, sc2, g2 = [m[:, None, :] for m in jnp.split(mod, 6, axis=-1)]
        h = _rms(x, norm1_g[l]) * (1.0 + sc1) + sh1
        proj = h @ w_in[l]
        c_q, c_kv, k_pe, dq, dk, dv = jnp.split(proj, IN_SPLITS, axis=-1)
        o_mla = _mla(c_q, c_kv, k_pe, positions, mla_cq_g[l], w_uq[l], mla_ckv_g[l], w_ukv[l],
                     mla_q_g[l], mla_k_g[l])
        o_diff = _diff_attn(dq, dk, dv, positions, rel_bias, diff_q_g[l], diff_k_g[l], lambda_q1[l],
                            lambda_k1[l], lambda_q2[l], lambda_k2[l], diff_subln_g[l], lambda_init)
        x = x + g1 * (jnp.concatenate([o_mla, o_diff], axis=-1) @ w_o[l])
        h2 = _rms(x, norm2_g[l]) * (1.0 + sc2) + sh2
        x = x + g2 * _hmoe(h2, w_rg[l], b_rg[l], w_re[l], b_re[l], w_gate[l], w_up[l], w_down[l])
    return x
```

```cpp
#include <hip/hip_runtime.h>
#include <math.h>
#include <stdint.h>

namespace {
constexpr int D = 1024, NB = 4, S = 4096, T = NB * S;
constexpr int INW = 2208;
constexpr int O_CQ = 0, O_CKV = 384, O_KPE = 640, O_DQ = 672, O_DK = 1184, O_DV = 1696;
constexpr float EPS = 1e-6f;

__device__ __forceinline__ float wave_sum(float v) { for (int o = 32; o > 0; o >>= 1) v += __shfl_xor(v, o); return v; }
__device__ __forceinline__ float wave_max(float v) { for (int o = 32; o > 0; o >>= 1) v = fmaxf(v, __shfl_xor(v, o)); return v; }
__device__ __forceinline__ float block_sum256(float v, float* sh) {
    v = wave_sum(v);
    if ((threadIdx.x & 63) == 0) sh[threadIdx.x >> 6] = v;
    __syncthreads();
    float r = (sh[0] + sh[1]) + (sh[2] + sh[3]);
    __syncthreads();
    return r;
}

__global__ void k_scalars(const float* rel_bias, const float* lq1, const float* lk1, const float* lq2, const float* lk2, float* scal, float* btab) {
    int tid = threadIdx.x;
    if (tid < 64) {
        float a = wave_sum(lq1[tid] * lk1[tid]);
        float b = wave_sum(lq2[tid] * lk2[tid]);
        if (tid == 0) scal[0] = expf(a) - expf(b) + 0.2f;
    }
    for (int i = tid; i < 4 * 257; i += blockDim.x) {
        int h = i / 257, rel = (i % 257) - 128;
        int n = rel < 0 ? -rel : rel;
        int bk;
        if (n < 8) bk = n;
        else { int nn = n * n; int lg = 31 - __clz(nn); bk = 8 + lg - 6; if (bk > 15) bk = 15; }
        if (rel > 0) bk += 16;
        btab[i] = rel_bias[bk * 4 + h];
    }
}

__global__ void k_mod(const float* c, const float* w_ada, const float* b_ada, float* mod) {
    __shared__ float sc[1024];
    int j = blockIdx.x * 256 + threadIdx.x, b = blockIdx.y;
    for (int k = threadIdx.x; k < 1024; k += 256) { float v = c[b * 1024 + k]; sc[k] = v / (1.f + expf(-v)); }
    __syncthreads();
    float acc = 0.f;
    for (int k = 0; k < 1024; ++k) acc += sc[k] * w_ada[(size_t)k * 6144 + j];
    mod[b * 6144 + j] = acc + b_ada[j];
}

__global__ void k_rope(const int* pos, float* cs) {
    int idx = blockIdx.x * 256 + threadIdx.x;
    int t = idx >> 4, i = idx & 15;
    const double base4[4] = {1.0, 0.5623413251903491, 0.31622776601683794, 0.1778279410038923};
    double f = (i & 3) == 0 ? base4[0] : (i & 3) == 1 ? base4[1] : (i & 3) == 2 ? base4[2] : base4[3];
    int q = i >> 2; f = q == 0 ? f : q == 1 ? f * 0.1 : q == 2 ? f * 0.01 : f * 0.001;
    double a = (double)pos[t] * f;
    double k = rint(a * 0.6366197723675814);
    double r = fma(-k, 1.5707963267948966, a); r = fma(-k, 6.123233995736766e-17, r);
    double r2 = r * r;
    double sn = r * (1.0 + r2 * (-1.0 / 6 + r2 * (1.0 / 120 + r2 * (-1.0 / 5040 + r2 * (1.0 / 362880 + r2 * (-1.0 / 39916800 + r2 * (1.0 / 6227020800.0)))))));
    double cn = 1.0 + r2 * (-0.5 + r2 * (1.0 / 24 + r2 * (-1.0 / 720 + r2 * (1.0 / 40320 + r2 * (-1.0 / 3628800 + r2 * (1.0 / 479001600.0 + r2 * (-1.0 / 87178291200.0)))))));
    long long ki = (long long)k; int qd = (int)(ki & 3);
    double cv = qd == 0 ? cn : qd == 1 ? -sn : qd == 2 ? -cn : sn;
    double sv = qd == 0 ? sn : qd == 1 ? cn : qd == 2 ? -sn : -cn;
    cs[(size_t)t * 32 + i] = (float)cv; cs[(size_t)t * 32 + 16 + i] = (float)sv;
}

__global__ void k_norm_mod(const float* x, const float* g, const float* sh, const float* sc, float* out) {
    __shared__ float red[4];
    int r = blockIdx.x, tid = threadIdx.x;
    float4 v = ((const float4*)(x + (size_t)r * 1024))[tid];
    float ss = block_sum256(v.x * v.x + v.y * v.y + v.z * v.z + v.w * v.w, red);
    float rs = rsqrtf(ss * (1.f / 1024.f) + EPS);
    float4 gg = ((const float4*)g)[tid], s4 = ((const float4*)sh)[tid], c4 = ((const float4*)sc)[tid];
    float4 o; o.x = v.x * rs * gg.x * (1.f + c4.x) + s4.x; o.y = v.y * rs * gg.y * (1.f + c4.y) + s4.y;
    o.z = v.z * rs * gg.z * (1.f + c4.z) + s4.z; o.w = v.w * rs * gg.w * (1.f + c4.w) + s4.w;
    ((float4*)(out + (size_t)r * 1024))[tid] = o;
}

__global__ void k_gemm(const float* A, int lda, const float* Bm, int ldb, float* C, int ldc, int M, int N, int K) {
    __shared__ float As[16][65];
    __shared__ float Bs[16][65];
    int tx = threadIdx.x & 15, ty = threadIdx.x >> 4;
    int m0 = blockIdx.y * 64, n0 = blockIdx.x * 64;
    float acc[4][4];
#pragma unroll
    for (int i = 0; i < 4; ++i)
#pragma unroll
        for (int j = 0; j < 4; ++j) acc[i][j] = 0.f;
    for (int k0 = 0; k0 < K; k0 += 16) {
        for (int i = threadIdx.x; i < 1024; i += 256) { int r = i >> 4, c = i & 15; As[c][r] = A[(size_t)(m0 + r) * lda + k0 + c]; }
        for (int i = threadIdx.x; i < 1024; i += 256) { int r = i >> 6, c = i & 63; Bs[r][c] = (n0 + c < N) ? Bm[(size_t)(k0 + r) * ldb + n0 + c] : 0.f; }
        __syncthreads();
#pragma unroll
        for (int k = 0; k < 16; ++k) {
            float a0 = As[k][ty * 4 + 0], a1 = As[k][ty * 4 + 1], a2 = As[k][ty * 4 + 2], a3 = As[k][ty * 4 + 3];
            float b0 = Bs[k][tx * 4 + 0], b1 = Bs[k][tx * 4 + 1], b2 = Bs[k][tx * 4 + 2], b3 = Bs[k][tx * 4 + 3];
            acc[0][0] += a0 * b0; acc[0][1] += a0 * b1; acc[0][2] += a0 * b2; acc[0][3] += a0 * b3;
            acc[1][0] += a1 * b0; acc[1][1] += a1 * b1; acc[1][2] += a1 * b2; acc[1][3] += a1 * b3;
            acc[2][0] += a2 * b0; acc[2][1] += a2 * b1; acc[2][2] += a2 * b2; acc[2][3] += a2 * b3;
            acc[3][0] += a3 * b0; acc[3][1] += a3 * b1; acc[3][2] += a3 * b2; acc[3][3] += a3 * b3;
        }
        __syncthreads();
    }
#pragma unroll
    for (int i = 0; i < 4; ++i)
#pragma unroll
        for (int j = 0; j < 4; ++j) { int n = n0 + tx * 4 + j; if (n < N) C[(size_t)(m0 + ty * 4 + i) * ldc + n] = acc[i][j]; }
}

__global__ void k_rms_seg(const float* in, int ld, int off, int n, const float* g, float* out) {
    int r = blockIdx.x * 4 + (threadIdx.x >> 6), lane = threadIdx.x & 63;
    const float* p = in + (size_t)r * ld + off;
    float ss = 0.f;
    for (int d = lane; d < n; d += 64) ss += p[d] * p[d];
    ss = wave_sum(ss);
    float rs = rsqrtf(ss / (float)n + EPS);
    for (int d = lane; d < n; d += 64) out[(size_t)r * n + d] = p[d] * rs * g[d];
}

__global__ void k_prep_mla(const float* q_raw, const float* kv_raw, const float* proj, const float* cs, const float* q_g, const float* k_g, float* Qm, float* Km) {
    int idx = blockIdx.x * 256 + threadIdx.x;
    int t = idx >> 3, h = idx & 7;
    const float* csr = cs + (size_t)t * 32;
    const float scale = 0.10206207261596577f;
    {
        const float* q = q_raw + (size_t)t * 768 + h * 96;
        float ss = 0.f;
        for (int d = 0; d < 96; ++d) ss += q[d] * q[d];
        float rs = rsqrtf(ss * (1.f / 96.f) + EPS);
        float* o = Qm + (size_t)t * 768 + h * 96;
        for (int d = 0; d < 64; ++d) o[d] = q[d] * rs * q_g[d] * scale;
        for (int i = 0; i < 16; ++i) {
            float x1 = q[64 + i] * rs * q_g[64 + i], x2 = q[80 + i] * rs * q_g[80 + i];
            float c = csr[i], s = csr[16 + i];
            o[64 + i] = (x1 * c - x2 * s) * scale; o[80 + i] = (x2 * c + x1 * s) * scale;
        }
    }
    {
        const float* kn = kv_raw + (size_t)t * 1024 + h * 128;
        const float* kp = proj + (size_t)t * INW + O_KPE;
        float ss = 0.f;
        for (int d = 0; d < 64; ++d) ss += kn[d] * kn[d];
        for (int d = 0; d < 32; ++d) ss += kp[d] * kp[d];
        float rs = rsqrtf(ss * (1.f / 96.f) + EPS);
        float* o = Km + (size_t)t * 768 + h * 96;
        for (int d = 0; d < 64; ++d) o[d] = kn[d] * rs * k_g[d];
        for (int i = 0; i < 16; ++i) {
            float x1 = kp[i] * rs * k_g[64 + i], x2 = kp[16 + i] * rs * k_g[80 + i];
            float c = csr[i], s = csr[16 + i];
            o[64 + i] = x1 * c - x2 * s; o[80 + i] = x2 * c + x1 * s;
        }
    }
}

__global__ void k_prep_diff(const float* proj, const float* q_g, const float* k_g, float* Qd, float* Kd) {
    int idx = blockIdx.x * 256 + threadIdx.x;
    int t = idx >> 3, hm = idx & 7;
    {
        const float* q = proj + (size_t)t * INW + O_DQ + hm * 64;
        float ss = 0.f;
        for (int d = 0; d < 64; ++d) ss += q[d] * q[d];
        float rs = rsqrtf(ss * (1.f / 64.f) + EPS);
        float* o = Qd + (size_t)t * 512 + hm * 64;
        for (int d = 0; d < 64; ++d) o[d] = q[d] * rs * q_g[d] * 0.125f;
    }
    {
        const float* k = proj + (size_t)t * INW + O_DK + hm * 64;
        float ss = 0.f;
        for (int d = 0; d < 64; ++d) ss += k[d] * k[d];
        float rs = rsqrtf(ss * (1.f / 64.f) + EPS);
        float* o = Kd + (size_t)t * 512 + hm * 64;
        for (int d = 0; d < 64; ++d) o[d] = k[d] * rs * k_g[d];
    }
}

template <int DQK, int DV, bool BIAS>
__global__ void k_attn_naive(const float* Q, int qs, int qh, const float* K, int ks, int kh, const float* V, int vs, int vh, float* O, int os, int oh,
                             int nheads, int hdiv, const int* pos, const float* btab) {
    __shared__ float sq[4][DQK];
    int w = threadIdx.x >> 6, lane = threadIdx.x & 63;
    int wave = blockIdx.x * 4 + w;
    int t = wave / nheads, h = wave % nheads;
    float* q = sq[w];
    for (int d = lane; d < DQK; d += 64) q[d] = Q[(size_t)t * qs + h * qh + d];
    __syncthreads();
    int nk = (t / 64 + 1) * 64;
    float m = -INFINITY, l = 0.f, o0 = 0.f, o1 = 0.f;
    int pt = BIAS ? pos[t] : 0;
    const float* Vh = V + (h / hdiv) * vh;
    for (int k0 = 0; k0 < nk; k0 += 64) {
        int key = k0 + lane;
        const float* kr = K + (size_t)key * ks + h * kh;
        float s = 0.f;
#pragma unroll 8
        for (int d = 0; d < DQK; d += 4) { float4 kk = *(const float4*)(kr + d); s += q[d] * kk.x + q[d + 1] * kk.y + q[d + 2] * kk.z + q[d + 3] * kk.w; }
        if (BIAS) { int rel = pos[key] - pt; rel = rel < -128 ? -128 : (rel > 128 ? 128 : rel); s += btab[(h / hdiv) * 257 + rel + 128]; }
        float mn = fmaxf(m, wave_max(s));
        float p = expf(s - mn), corr = expf(m - mn);
        l = l * corr + wave_sum(p); o0 *= corr; o1 *= corr;
#pragma unroll 8
        for (int j = 0; j < 64; ++j) {
            float pj = __shfl(p, j);
            const float* vr = Vh + (size_t)(k0 + j) * vs;
            o0 += pj * vr[lane];
            if (DV == 128) o1 += pj * vr[64 + lane];
        }
        m = mn;
    }
    float* orow = O + (size_t)t * os + h * oh;
    orow[lane] = o0 / l;
    if (DV == 128) orow[64 + lane] = o1 / l;
}

__global__ void k_diff_combine(const float* tmpO, const float* scal, const float* subln_g, float* Ocat) {
    int wave = blockIdx.x * 4 + (threadIdx.x >> 6), lane = threadIdx.x & 63;
    int t = wave >> 2, h = wave & 3;
    float lam = scal[0];
    const float* a0 = tmpO + (size_t)t * 1024 + (h * 2) * 128;
    const float* a1 = a0 + 128;
    float v0 = a0[lane] - lam * a1[lane], v1 = a0[64 + lane] - lam * a1[64 + lane];
    float ss = wave_sum(v0 * v0 + v1 * v1);
    float rs = rsqrtf(ss * (1.f / 128.f) + EPS);
    float* o = Ocat + (size_t)t * 1024 + 512 + h * 128;
    o[lane] = v0 * rs * subln_g[lane] * 0.8f; o[64 + lane] = v1 * rs * subln_g[64 + lane] * 0.8f;
}

__global__ void k_resid_norm2(const float* x, const float* ao, const float* g1, const float* g, const float* sh, const float* sc, float* x1, float* h2) {
    __shared__ float red[4];
    int r = blockIdx.x, tid = threadIdx.x;
    float4 xv = ((const float4*)(x + (size_t)r * 1024))[tid], av = ((const float4*)(ao + (size_t)r * 1024))[tid], gv = ((const float4*)g1)[tid];
    float4 v; v.x = xv.x + gv.x * av.x; v.y = xv.y + gv.y * av.y; v.z = xv.z + gv.z * av.z; v.w = xv.w + gv.w * av.w;
    ((float4*)(x1 + (size_t)r * 1024))[tid] = v;
    float ss = block_sum256(v.x * v.x + v.y * v.y + v.z * v.z + v.w * v.w, red);
    float rs = rsqrtf(ss * (1.f / 1024.f) + EPS);
    float4 gg = ((const float4*)g)[tid], s4 = ((const float4*)sh)[tid], c4 = ((const float4*)sc)[tid];
    float4 o; o.x = v.x * rs * gg.x * (1.f + c4.x) + s4.x; o.y = v.y * rs * gg.y * (1.f + c4.y) + s4.y;
    o.z = v.z * rs * gg.z * (1.f + c4.z) + s4.z; o.w = v.w * rs * gg.w * (1.f + c4.w) + s4.w;
    ((float4*)(h2 + (size_t)r * 1024))[tid] = o;
}

__global__ void k_moe_naive(const float* h2, float* out, const float* g2, const float* w_rg, const float* b_rg, const float* w_re, const float* b_re,
                            const float* w_gate, const float* w_up, const float* w_down) {
    __shared__ float st[1024];
    __shared__ float lg[20];
    __shared__ float he[512];
    __shared__ int sel[2];
    __shared__ float selw[2];
    int r = blockIdx.x, tid = threadIdx.x, w = tid >> 6, lane = tid & 63;
    ((float4*)st)[tid] = ((const float4*)(h2 + (size_t)r * 1024))[tid];
    __syncthreads();
    for (int o = w; o < 20; o += 4) {
        float a = 0.f;
        if (o < 4) { for (int k = lane; k < 1024; k += 64) a += st[k] * w_rg[k * 4 + o]; }
        else { for (int k = lane; k < 1024; k += 64) a += st[k] * w_re[k * 16 + (o - 4)]; }
        a = wave_sum(a);
        if (lane == 0) lg[o] = a + (o < 4 ? b_rg[o] : b_re[o - 4]);
    }
    __syncthreads();
    if (tid == 0) {
        int gi = 0; float gm = lg[0];
        for (int i = 1; i < 4; ++i) if (lg[i] > gm) { gm = lg[i]; gi = i; }
        float den = 0.f;
        for (int i = 0; i < 4; ++i) den += expf(lg[i] - gm);
        float gw = 1.f / den;
        const float* e = lg + 4 + gi * 4;
        int i1 = 0; float v1 = e[0];
        for (int i = 1; i < 4; ++i) if (e[i] > v1) { v1 = e[i]; i1 = i; }
        int i2 = -1; float v2 = -INFINITY;
        for (int i = 0; i < 4; ++i) if (i != i1 && e[i] > v2) { v2 = e[i]; i2 = i; }
        float e2 = expf(v2 - v1);
        sel[0] = gi * 4 + i1; sel[1] = gi * 4 + i2;
        selw[0] = gw / (1.f + e2); selw[1] = gw * e2 / (1.f + e2);
    }
    __syncthreads();
    float y0 = 0.f, y1 = 0.f, y2 = 0.f, y3 = 0.f;
    for (int j = 0; j < 2; ++j) {
        int e = sel[j]; float wgt = selw[j];
        const float* Wg = w_gate + (size_t)e * 1024 * 512;
        const float* Wu = w_up + (size_t)e * 1024 * 512;
        const float* Wd = w_down + (size_t)e * 512 * 1024;
        float ga0 = 0.f, ga1 = 0.f, up0 = 0.f, up1 = 0.f;
        for (int k = 0; k < 1024; ++k) {
            float s = st[k];
            ga0 += s * Wg[(size_t)k * 512 + tid]; ga1 += s * Wg[(size_t)k * 512 + 256 + tid];
            up0 += s * Wu[(size_t)k * 512 + tid]; up1 += s * Wu[(size_t)k * 512 + 256 + tid];
        }
        __syncthreads();
        he[tid] = ga0 / (1.f + expf(-ga0)) * up0; he[256 + tid] = ga1 / (1.f + expf(-ga1)) * up1;
        __syncthreads();
        float a0 = 0.f, a1 = 0.f, a2 = 0.f, a3 = 0.f;
        for (int k = 0; k < 512; ++k) {
            float s = he[k]; const float* wr = Wd + (size_t)k * 1024;
            a0 += s * wr[tid]; a1 += s * wr[256 + tid]; a2 += s * wr[512 + tid]; a3 += s * wr[768 + tid];
        }
        y0 += wgt * a0; y1 += wgt * a1; y2 += wgt * a2; y3 += wgt * a3;
    }
    float* o = out + (size_t)r * 1024;
    o[tid] += g2[tid] * y0; o[256 + tid] += g2[256 + tid] * y1; o[512 + tid] += g2[512 + tid] * y2; o[768 + tid] += g2[768 + tid] * y3;
}
}

extern "C" void kernel_launch(void* const* d_in, const int* in_sizes, int n_in, void* d_out, int out_size, void* d_ws, size_t ws_size, hipStream_t stream) {
    const float* x = (const float*)d_in[0];
    const float* c = (const float*)d_in[1];
    const int* positions = (const int*)d_in[2];
    const float* rel_bias = (const float*)d_in[3];
    const float* w_ada = (const float*)d_in[4];
    const float* b_ada = (const float*)d_in[5];
    const float* norm1_g = (const float*)d_in[6];
    const float* w_in = (const float*)d_in[7];
    const float* mla_cq_g = (const float*)d_in[8];
    const float* w_uq = (const float*)d_in[9];
    const float* mla_ckv_g = (const float*)d_in[10];
    const float* w_ukv = (const float*)d_in[11];
    const float* mla_q_g = (const float*)d_in[12];
    const float* mla_k_g = (const float*)d_in[13];
    const float* diff_q_g = (const float*)d_in[14];
    const float* diff_k_g = (const float*)d_in[15];
    const float* lq1 = (const float*)d_in[16];
    const float* lk1 = (const float*)d_in[17];
    const float* lq2 = (const float*)d_in[18];
    const float* lk2 = (const float*)d_in[19];
    const float* subln_g = (const float*)d_in[20];
    const float* w_o = (const float*)d_in[21];
    const float* norm2_g = (const float*)d_in[22];
    const float* w_rg = (const float*)d_in[23];
    const float* b_rg = (const float*)d_in[24];
    const float* w_re = (const float*)d_in[25];
    const float* b_re = (const float*)d_in[26];
    const float* w_gate = (const float*)d_in[27];
    const float* w_up = (const float*)d_in[28];
    const float* w_down = (const float*)d_in[29];
    float* out = (float*)d_out;

    float* ws = (float*)d_ws;
    size_t off = 0;
    auto take = [&](size_t n) { float* p = ws + off; off += (n + 63) & ~(size_t)63; return p; };
    float* mod = take(4 * 6144);
    float* scal = take(64);
    float* btab = take(4 * 257);
    float* cs = take((size_t)T * 32);
    float* h = take((size_t)S * 1024);
    float* proj = take((size_t)S * INW);
    float* cqn = take((size_t)S * 384);
    float* ckvn = take((size_t)S * 256);
    float* q_raw = take((size_t)S * 768);
    float* kv_raw = take((size_t)S * 1024);
    float* Qm = take((size_t)S * 768);
    float* Km = take((size_t)S * 768);
    float* Qd = take((size_t)S * 512);
    float* Kd = take((size_t)S * 512);
    float* tmpO = take((size_t)S * 1024);
    float* Ocat = take((size_t)S * 1024);
    float* ao = take((size_t)S * 1024);

    k_scalars<<<1, 256, 0, stream>>>(rel_bias, lq1, lk1, lq2, lk2, scal, btab);
    k_mod<<<dim3(24, 4), 256, 0, stream>>>(c, w_ada, b_ada, mod);
    k_rope<<<T * 16 / 256, 256, 0, stream>>>(positions, cs);
    for (int b = 0; b < NB; ++b) {
        const float* xb = x + (size_t)b * S * 1024;
        float* ob = out + (size_t)b * S * 1024;
        const float* mb = mod + b * 6144;
        const int* pb = positions + b * S;
        const float* csb = cs + (size_t)b * S * 32;
        k_norm_mod<<<S, 256, 0, stream>>>(xb, norm1_g, mb + 0, mb + 1024, h);
        k_gemm<<<dim3((INW + 63) / 64, S / 64), 256, 0, stream>>>(h, 1024, w_in, INW, proj, INW, S, INW, 1024);
        k_rms_seg<<<S / 4, 256, 0, stream>>>(proj, INW, O_CQ, 384, mla_cq_g, cqn);
        k_rms_seg<<<S / 4, 256, 0, stream>>>(proj, INW, O_CKV, 256, mla_ckv_g, ckvn);
        k_gemm<<<dim3(768 / 64, S / 64), 256, 0, stream>>>(cqn, 384, w_uq, 768, q_raw, 768, S, 768, 384);
        k_gemm<<<dim3(1024 / 64, S / 64), 256, 0, stream>>>(ckvn, 256, w_ukv, 1024, kv_raw, 1024, S, 1024, 256);
        k_prep_mla<<<S * 8 / 256, 256, 0, stream>>>(q_raw, kv_raw, proj, csb, mla_q_g, mla_k_g, Qm, Km);
        k_prep_diff<<<S * 8 / 256, 256, 0, stream>>>(proj, diff_q_g, diff_k_g, Qd, Kd);
        k_attn_naive<96, 64, false><<<S * 8 / 4, 256, 0, stream>>>(Qm, 768, 96, Km, 768, 96, kv_raw + 64, 1024, 128, Ocat, 1024, 64, 8, 1, pb, btab);
        k_attn_naive<64, 128, true><<<S * 8 / 4, 256, 0, stream>>>(Qd, 512, 64, Kd, 512, 64, proj + O_DV, INW, 128, tmpO, 1024, 128, 8, 2, pb, btab);
        k_diff_combine<<<S * 4 / 4, 256, 0, stream>>>(tmpO, scal, subln_g, Ocat);
        k_gemm<<<dim3(1024 / 64, S / 64), 256, 0, stream>>>(Ocat, 1024, w_o, 1024, ao, 1024, S, 1024, 1024);
        k_resid_norm2<<<S, 256, 0, stream>>>(xb, ao, mb + 2048, norm2_g, mb + 3072, mb + 4096, ob, h);
        k_moe_naive<<<S, 256, 0, stream>>>(h, ob, mb + 5120, w_rg, b_rg, w_re, b_re, w_gate, w_up, w_down);
    }
}
```

```cpp
#include <hip/hip_runtime.h>
#include <cstdio>
#include <cstdint>
#include <math.h>

#ifndef STEP
#define STEP 6
#endif

#define GAS __attribute__((address_space(1)))
#define LAS __attribute__((address_space(3)))
typedef unsigned short bf16;
typedef unsigned short bf16_t;
typedef short bf16x8 __attribute__((ext_vector_type(8)));
typedef float f32x4 __attribute__((ext_vector_type(4)));
typedef float f32x16 __attribute__((ext_vector_type(16)));
typedef unsigned u32x4 __attribute__((ext_vector_type(4)));
typedef unsigned u32x2 __attribute__((ext_vector_type(2)));
typedef GAS unsigned gu32;

constexpr int D = 1024, NB = 4, S = 4096, T = NB * S;
constexpr int PW = 2304;
constexpr int P_CQ = 0, P_CKV = 384, P_KPE = 640, P_DQ = 768, P_DK = 1280, P_DV = 1792;
constexpr float EPS = 1e-6f;
constexpr float LOG2E = 1.4426950408889634f;

constexpr size_t MiB = 1u << 20;
constexpr size_t WS_CTL = 0, CTL_ZERO_BYTES = 256 * 1024;
constexpr size_t WS_MOD = 1 * MiB;
constexpr size_t WS_SCAL = 1 * MiB + 128 * 1024;
constexpr size_t WS_CS = 2 * MiB;
constexpr size_t WS_WIN = 4 * MiB;
constexpr size_t WS_WUQ = 9 * MiB;
constexpr size_t WS_WUKV = 10 * MiB;
constexpr size_t WS_WO = 11 * MiB;
constexpr size_t WS_WGU = 13 * MiB;
constexpr size_t WS_WD = 45 * MiB;
constexpr size_t WS_HA = 61 * MiB;
constexpr size_t WS_PROJ = 93 * MiB;
constexpr size_t WS_QRAW = 165 * MiB;
constexpr size_t WS_KVRAW = 189 * MiB;
constexpr size_t WS_KM = 221 * MiB;
constexpr size_t WS_H2 = 165 * MiB;
constexpr size_t WS_HB = 93 * MiB;
constexpr size_t WS_LIST = 245 * MiB;
constexpr size_t WS_WL = 247 * MiB;
constexpr size_t WS_END = 256 * MiB;
constexpr int CW_TMO = 0, CW_BAR = 4096, CW_QUEUE = 8192  , CW_BCNT = 8448  ;

constexpr int RING_BYTES = 131072;
constexpr int RS_OFF = RING_BYTES;
constexpr int LDSCTL_OFF = RS_OFF + 2048;
constexpr int LDS_BYTES = 147456;
constexpr int NWAVES = 8;

#define LDS_WAIT() asm volatile("s_waitcnt lgkmcnt(0)" ::: "memory")
#define VM_WAIT() asm volatile("s_waitcnt vmcnt(0)" ::: "memory")
__device__ __forceinline__ unsigned f2bf(float f) { unsigned u = __builtin_bit_cast(unsigned, f); return (u + 0x7fffu + ((u >> 16) & 1u)) >> 16; }
__device__ __forceinline__ unsigned pk2(float lo, float hi) { return f2bf(lo) | (f2bf(hi) << 16); }
__device__ __forceinline__ float bf2f(unsigned short v) { return __builtin_bit_cast(float, (unsigned)v << 16); }
__device__ __forceinline__ float wave_sum(float v) {
#pragma unroll
    for (int o = 1; o < 64; o <<= 1) v += __shfl_xor(v, o);
    return v;
}
__device__ __forceinline__ float wave_max(float v) {
#pragma unroll
    for (int o = 1; o < 64; o <<= 1) v = fmaxf(v, __shfl_xor(v, o));
    return v;
}

#define XB_TMO      128
#define XB_XCNT(j)  (256  + 64 * (j))
#define XB_XSUB(j)  (1280 + 64 * (j))
#define XB_XGEN(j)  (2304 + 64 * (j))
#define XB_TOP      3328
#define XB_TOPGEN   3392
#define XCD_BAR_WORDS 3456
#define XB_SPIN_CAP (1u << 18)
__device__ __forceinline__ unsigned xb_ld(unsigned* p)              { return __hip_atomic_load(p, __ATOMIC_RELAXED, __HIP_MEMORY_SCOPE_AGENT); }
__device__ __forceinline__ unsigned xb_add(unsigned* p, unsigned v) { return __hip_atomic_fetch_add(p, v, __ATOMIC_RELAXED, __HIP_MEMORY_SCOPE_AGENT); }
__device__ __forceinline__ unsigned xb_xcc_id() { return (unsigned)__builtin_amdgcn_s_getreg((3 << 11) | 20) & 0xFu; }
#define XB_SPIN(cond, bar) do { unsigned _sp = 0; while (cond) { __builtin_amdgcn_s_sleep(1); \
    if ((++_sp & 255u) == 0u) { if (xb_ld(&(bar)[XB_TMO])) break; if (_sp > XB_SPIN_CAP) { atomicAdd(&(bar)[XB_TMO], 1u); break; } } } } while (0)
struct XcdBarrier { unsigned* bar; unsigned x; volatile LAS unsigned* st; };
__device__ __forceinline__ XcdBarrier xcd_barrier_post(unsigned* bar, volatile LAS unsigned* st) {
    XcdBarrier b; b.bar = bar; b.x = xb_xcc_id(); b.st = st;
    if (threadIdx.x == 0) (void)xb_add(&bar[XB_XCNT(b.x)], 1u);
    return b;
}
__device__ __forceinline__ void xcd_barrier_complete(unsigned* bar, unsigned x, unsigned& nloc, unsigned& nx) {
    const unsigned G = gridDim.x * gridDim.y * gridDim.z;
    unsigned sum, cnt, mine, sp = 0u;
    for (;;) {
        sum = 0u; cnt = 0u; mine = 0u;
#pragma unroll
        for (unsigned j = 0; j < 16; ++j) { const unsigned c = xb_ld(&bar[XB_XCNT(j)]); sum += c; cnt += (c > 0u) ? 1u : 0u; mine = (j == x) ? c : mine; }
        if (sum == G) break;
        __builtin_amdgcn_s_sleep(1);
        if ((++sp & 255u) == 0u) { if (xb_ld(&bar[XB_TMO])) break; if (sp > XB_SPIN_CAP) { atomicAdd(&bar[XB_TMO], 1u); break; } }
    }
    nloc = mine > 0u ? mine : 1u; nx = cnt > 0u ? cnt : 1u;
}
__device__ __forceinline__ void xcd_barrier(const XcdBarrier& b) {
    asm volatile("s_waitcnt vmcnt(0)" ::: "memory");
    __syncthreads();
    if (threadIdx.x == 0) {
        unsigned* bar = b.bar;
        __builtin_amdgcn_s_waitcnt(0);
        unsigned nloc = b.st[0], nx = b.st[1];
        if (nloc == 0u) { xcd_barrier_complete(bar, b.x, nloc, nx); b.st[0] = nloc; b.st[1] = nx; }
        const unsigned old = xb_add(&bar[XB_XSUB(b.x)], 1u);
        const unsigned gen = old / nloc;
        if (old + 1u == (gen + 1u) * nloc) {
            __builtin_amdgcn_fence(__ATOMIC_RELEASE, "agent");
            asm volatile("s_waitcnt vmcnt(0)" ::: "memory");
            const unsigned og = xb_add(&bar[XB_TOP], 1u);
            const unsigned tg = og / nx;
            if (og + 1u == (tg + 1u) * nx) xb_add(&bar[XB_TOPGEN], 1u);
            else XB_SPIN(xb_ld(&bar[XB_TOPGEN]) == tg, bar);
            __builtin_amdgcn_fence(__ATOMIC_ACQUIRE, "agent");
            xb_add(&bar[XB_XGEN(b.x)], 1u);
            asm volatile("s_waitcnt vmcnt(0)" ::: "memory");
        } else {
            XB_SPIN(xb_ld(&bar[XB_XGEN(b.x)]) == gen, bar);
            __builtin_amdgcn_fence(__ATOMIC_ACQUIRE, "agent");
            asm volatile("s_waitcnt vmcnt(0)" ::: "memory");
        }
    }
    __syncthreads();
}

namespace pg8 {
constexpr int BM = 256, BK = 64, HALF = 128, HTB = HALF * BK * 2, STAGE_BYTES = 8 * HTB, NXCD = 8, WGM = 8;
__host__ __device__ __forceinline__ int lds_byte(int r, int c) { const int st = (r >> 4) * 2 + (c >> 5), rr = r & 15, cc = c & 31, ob = rr * 64 + cc * 2; return st * 1024 + (ob ^ (((ob >> 9) & 1) << 5)); }
__host__ __device__ __forceinline__ void stage_rc(int b, int& R, int& C) { const int st = b / 1024, sb = b % 1024, swz = sb ^ (((sb >> 9) & 1) << 5); R = (st >> 1) * 16 + swz / 64; C = (st & 1) * 32 + (swz % 64) / 2; }
__host__ __device__ __forceinline__ int perm32(int rho) { const int n = rho >> 4, i = rho & 15; return 8 * (i >> 2) + 4 * n + (i & 3); }

struct Unit { int pm, pn, aux; };

struct DenseSched {
    int nM, nN, nwg, G, c; const char* Bt; unsigned lda_b, ldb_b;
    __device__ void init(int M, int N, int G_, int c_, const void* Bt_, int lda, int ldb) { nM = M / BM; nN = N / BM; nwg = nM * nN; G = G_; c = c_; Bt = (const char*)Bt_; lda_b = (unsigned)lda * 2u; ldb_b = (unsigned)ldb * 2u; }
    __device__ __forceinline__ bool next(int i, Unit& u) const {
        const long L = (long)i * G + c; if (L >= nwg) return false;
        int wgid = (int)L; { const int q = nwg / NXCD, r = nwg % NXCD, xcd = wgid % NXCD, off = wgid / NXCD; wgid = (xcd < r ? xcd * (q + 1) : r * (q + 1) + (xcd - r) * q) + off; }
        const int nig = WGM * nN, gid = wgid / nig, fm = gid * WGM, gsz = (nM - fm) < WGM ? (nM - fm) : WGM;
        u.pm = fm + ((wgid % nig) % gsz); u.pn = (wgid % nig) / gsz; u.aux = 0; return true;
    }
    __device__ __forceinline__ unsigned a_row_off(const Unit& u, int row) const { return (unsigned)(u.pm * BM + row) * lda_b; }
    __device__ __forceinline__ const char* b_tile(const Unit& u, int kt) const { return Bt + (size_t)u.pn * BM * ldb_b + (size_t)kt * (BK * 2); }
};

__device__ __forceinline__ unsigned cvt_pk_bf16(float lo, float hi) { unsigned r; asm volatile("v_cvt_pk_bf16_f32 %0, %1, %2" : "=v"(r) : "v"(lo), "v"(hi)); return r; }

struct EpiStoreBf16 {
    static constexpr bool PERM = true;
    bf16_t* O; int ldc; bool use_rs;
    __device__ __forceinline__ void prep(const Unit&, int, LAS unsigned char*) const {}
    __device__ __forceinline__ void operator()(const f32x4 (&acc)[2][2][4][2], const Unit& u, int ui, int wr, int wc, int fr, int fq, LAS unsigned char* lds) const {
        const int row0 = u.pm * BM + wr * 64 + fr, col0 = u.pn * BM + wc * 32 + 8 * fq;
#pragma unroll
        for (int ai = 0; ai < 2; ++ai)
#pragma unroll
            for (int m = 0; m < 4; ++m) { bf16_t* rowp = O + (size_t)(row0 + ai * HALF + m * 16) * ldc + col0;
#pragma unroll
                for (int bj = 0; bj < 2; ++bj) { const f32x4 v0 = acc[ai][bj][m][0], v1 = acc[ai][bj][m][1];
                    u32x4 w; w.x = cvt_pk_bf16(v0[0], v0[1]); w.y = cvt_pk_bf16(v0[2], v0[3]); w.z = cvt_pk_bf16(v1[0], v1[1]); w.w = cvt_pk_bf16(v1[2], v1[3]);
                    *(u32x4*)(rowp + bj * HALF) = w; } }
    }
};

struct EpiStoreBf16RS {
    static constexpr bool PERM = true;
    bf16_t* O; int ldc; const bf16_t* A; int lda; int K;
    __device__ __forceinline__ void prep(const Unit& u, int ui, LAS unsigned char* lds) const {
        LAS float* tab = (LAS float*)(lds + RS_OFF) + (ui & 1) * 256;
        const int tid = threadIdx.x, wid = tid >> 6, lane = tid & 63;
        const float invK = 1.0f / (float)K;
#pragma unroll 1
        for (int i = 0; i < 4; ++i) {
            const int row = wid * 32 + i * 8 + (lane >> 3);
            const bf16_t* p = A + (size_t)(u.pm * BM + row) * lda + (lane & 7) * 8;
            float ss = 0.f;
            for (int j = 0; j < K / 64; ++j) { const u32x4 v = *(const u32x4*)(p + 64 * j);
#pragma unroll
                for (int e = 0; e < 4; ++e) { const float lo = __builtin_bit_cast(float, v[e] << 16), hi = __builtin_bit_cast(float, v[e] & 0xffff0000u); ss += lo * lo + hi * hi; } }
            ss += __shfl_xor(ss, 1); ss += __shfl_xor(ss, 2); ss += __shfl_xor(ss, 4);
            if ((lane & 7) == 0) tab[row] = rsqrtf(ss * invK + EPS);
        }
    }
    __device__ __forceinline__ void operator()(const f32x4 (&acc)[2][2][4][2], const Unit& u, int ui, int wr, int wc, int fr, int fq, LAS unsigned char* lds) const {
        const LAS float* tab = (const LAS float*)(lds + RS_OFF) + (ui & 1) * 256;
        const int row0 = u.pm * BM + wr * 64 + fr, col0 = u.pn * BM + wc * 32 + 8 * fq;
#pragma unroll
        for (int ai = 0; ai < 2; ++ai)
#pragma unroll
            for (int m = 0; m < 4; ++m) { bf16_t* rowp = O + (size_t)(row0 + ai * HALF + m * 16) * ldc + col0; const float rs = tab[ai * HALF + wr * 64 + m * 16 + fr];
#pragma unroll
                for (int bj = 0; bj < 2; ++bj) { const f32x4 v0 = acc[ai][bj][m][0] * rs, v1 = acc[ai][bj][m][1] * rs;
                    u32x4 w; w.x = cvt_pk_bf16(v0[0], v0[1]); w.y = cvt_pk_bf16(v0[2], v0[3]); w.z = cvt_pk_bf16(v1[0], v1[1]); w.w = cvt_pk_bf16(v1[2], v1[3]);
                    *(u32x4*)(rowp + bj * HALF) = w; } }
    }
};

struct EpiResid {
    static constexpr bool PERM = false;
    const float* x; float* out; const float* mod;
    __device__ __forceinline__ void prep(const Unit&, int, LAS unsigned char*) const {}
    __device__ __forceinline__ void operator()(const f32x4 (&acc)[2][2][4][2], const Unit& u, int ui, int wr, int wc, int fr, int fq, LAS unsigned char* lds) const {
        const int b = (u.pm * BM) / S; const int col0 = u.pn * BM + wc * 32 + 4 * fq;
        f32x4 gv[2][2];
#pragma unroll
        for (int bj = 0; bj < 2; ++bj)
#pragma unroll
            for (int n = 0; n < 2; ++n) gv[bj][n] = *(const f32x4*)(mod + b * 6144 + 2048 + col0 + bj * HALF + n * 16);
#pragma unroll
        for (int ai = 0; ai < 2; ++ai)
#pragma unroll
            for (int m = 0; m < 4; ++m) { const size_t off = (size_t)(u.pm * BM + ai * HALF + wr * 64 + m * 16 + fr) * 1024 + col0;
#pragma unroll
                for (int bj = 0; bj < 2; ++bj)
#pragma unroll
                    for (int n = 0; n < 2; ++n) { const f32x4 xv = *(const f32x4*)(x + off + bj * HALF + n * 16); *(f32x4*)(out + off + bj * HALF + n * 16) = xv + gv[bj][n] * acc[ai][bj][m][n]; } }
    }
};

constexpr int MOE_TAB_OFF = LDSCTL_OFF + 128;
__device__ __forceinline__ void moe_pair(int bk, int& elo, int& ehi) { const int gi = bk / 6, ix = bk % 6; const int a = ix < 3 ? 0 : (ix < 5 ? 1 : 2); const int b2 = ix < 3 ? ix + 1 : (ix < 5 ? ix - 1 : 3); elo = gi * 4 + a; ehi = gi * 4 + b2; }
struct MoeSched {
    int G, c, npn, ntiles; const LAS int* tab; const int* list; const char* W; unsigned a_pitch; bool gather; bool down;
    __device__ __forceinline__ bool next(int i, Unit& u) const {
        const int L = i * G + c; if (L >= ntiles * npn) return false;
        u.pm = L / npn; u.pn = L % npn; int bk = 0;
#pragma unroll 1
        for (int k = 1; k < 24; ++k) if (tab[k] <= u.pm) bk = k;
        u.aux = bk; return true;
    }
    __device__ __forceinline__ unsigned a_row_off(const Unit& u, int row) const {
        if (!gather) return (unsigned)(u.pm * BM + row) * a_pitch;
        const int bk = u.aux, r = (u.pm - tab[bk]) * BM + row, n = tab[32 + bk];
        int tok = list[bk * 16384 + (r < n ? r : 0)]; tok = tok < 0 ? 0 : (tok > T - 1 ? T - 1 : tok);
        return (unsigned)tok * a_pitch;
    }
    __device__ __forceinline__ const char* b_tile(const Unit& u, int kt) const {
        int elo, ehi; moe_pair(u.aux, elo, ehi);
        if (!down) { const int e = u.pn < 4 ? elo : ehi; return W + ((size_t)(e * 4 + (u.pn & 3)) * 256) * 2048 + (size_t)kt * 128; }
        const int e = kt < 8 ? elo : ehi;
        return W + ((size_t)e * 1024 + u.pn * 256) * 1024 + (size_t)(kt & 7) * 128;
    }
};
struct EpiSwiglu {
    static constexpr bool PERM = true;
    bf16_t* H; const float* wl; const LAS int* tab;
    __device__ __forceinline__ void prep(const Unit&, int, LAS unsigned char*) const {}
    __device__ __forceinline__ void operator()(const f32x4 (&acc)[2][2][4][2], const Unit& u, int ui, int wr, int wc, int fr, int fq, LAS unsigned char* lds) const {
        const int bk = u.aux, n = tab[32 + bk], r0 = (u.pm - tab[bk]) * BM; const int col0 = u.pn * 128 + wc * 32 + 8 * fq; const int which = u.pn < 4 ? 0 : 1;
#pragma unroll
        for (int ai = 0; ai < 2; ++ai)
#pragma unroll
            for (int m = 0; m < 4; ++m) { const int row = ai * HALF + wr * 64 + m * 16 + fr; const int r = r0 + row;
                const float w = r < n ? wl[((size_t)bk * 16384 + r) * 2 + which] : 0.f;
                float hv[8];
#pragma unroll
                for (int nn = 0; nn < 2; ++nn)
#pragma unroll
                    for (int e = 0; e < 4; ++e) { const float g = acc[ai][0][m][nn][e], up = acc[ai][1][m][nn][e]; hv[nn * 4 + e] = g * __builtin_amdgcn_rcpf(1.f + __builtin_amdgcn_exp2f(-g * LOG2E)) * up * w; }
                u32x4 o; o.x = cvt_pk_bf16(hv[0], hv[1]); o.y = cvt_pk_bf16(hv[2], hv[3]); o.z = cvt_pk_bf16(hv[4], hv[5]); o.w = cvt_pk_bf16(hv[6], hv[7]);
                *(u32x4*)(H + (size_t)(u.pm * BM + row) * 1024 + col0) = o; }
    }
};
struct EpiMoeOut {
    static constexpr bool PERM = false;
    float* out; const float* mod; const int* list; const LAS int* tab;
    __device__ __forceinline__ void prep(const Unit&, int, LAS unsigned char*) const {}
    __device__ __forceinline__ void operator()(const f32x4 (&acc)[2][2][4][2], const Unit& u, int ui, int wr, int wc, int fr, int fq, LAS unsigned char* lds) const {
        const int bk = u.aux, n = tab[32 + bk], r0 = (u.pm - tab[bk]) * BM; const int col0 = u.pn * BM + wc * 32 + 4 * fq;
#pragma unroll
        for (int ai = 0; ai < 2; ++ai)
#pragma unroll
            for (int m = 0; m < 4; ++m) { const int r = r0 + ai * HALF + wr * 64 + m * 16 + fr;
                if (r < n) { const int tok = list[bk * 16384 + r]; const int b = tok / S; float* op = out + (size_t)tok * 1024 + col0; const float* gp = mod + b * 6144 + 5120 + col0;
#pragma unroll
                    for (int bj = 0; bj < 2; ++bj)
#pragma unroll
                        for (int nn = 0; nn < 2; ++nn) { const f32x4 xv = *(const f32x4*)(op + bj * HALF + nn * 16), gv = *(const f32x4*)(gp + bj * HALF + nn * 16); *(f32x4*)(op + bj * HALF + nn * 16) = xv + gv * acc[ai][bj][m][nn]; } } }
    }
};

template <class Epi, class Sched, bool ALIGN_EPI>
__device__ __forceinline__ void gemm_phase(LAS unsigned char* lds, const char* Abase, int ldb, int K, const Sched& S, const Epi& E) {
    const int tid = threadIdx.x, wid = __builtin_amdgcn_readfirstlane(tid >> 6), lane = tid & 63, wr = wid >> 2, wc = wid & 3, fr = lane & 15, fq = lane >> 4;
    const int nt = K / BK;
    int RA[2], CA[2]; unsigned voffB[2];
#pragma unroll
    for (int i = 0; i < 2; ++i) { int R, C; stage_rc(tid * 16 + i * 8192, R, C); const int Rb = Epi::PERM ? ((R & ~31) + perm32(R & 31)) : R;
        RA[i] = R; CA[i] = C * 2; voffB[i] = (unsigned)(Rb * ldb + C) * 2u; }
    const size_t hstepB = (size_t)HALF * ldb * 2;
    const unsigned ldsw = (unsigned)wid * 1024u;
    const int aoff = lds_byte(wr * 64 + fr, fq * 8), boff = lds_byte(wc * 32 + fr, fq * 8);
#define PG8_SA(b, h) (((b) * 2 + (h)) * HTB)
#define PG8_SB(b, h) ((4 + (b) * 2 + (h)) * HTB)
#define PG8_GLDS(gp, bufoff, i) __builtin_amdgcn_global_load_lds((const unsigned*)(gp), (LAS unsigned*)(lds + (bufoff) + ldsw + (i) * 8192), 16, 0, 0)
#define PG8_STAGE_A(bufoff, VO, h, kt) do { _Pragma("unroll") for (int _i = 0; _i < 2; ++_i) PG8_GLDS(Abase + (VO)[h][_i] + (size_t)(kt) * (BK * 2), bufoff, _i); } while (0)
#define PG8_STAGE_B(bufoff, bp, h) do { _Pragma("unroll") for (int _i = 0; _i < 2; ++_i) PG8_GLDS((bp) + (h) * hstepB + voffB[_i], bufoff, _i); } while (0)
#define PG8_LDA(dst, b, h) do { _Pragma("unroll") for (int m = 0; m < 4; ++m) _Pragma("unroll") for (int k = 0; k < 2; ++k) dst[m][k] = *(const LAS bf16x8*)(lds + PG8_SA(b, h) + aoff + m * 2048 + k * 1024); } while (0)
#define PG8_LDB(dst, b, h) do { _Pragma("unroll") for (int n = 0; n < 2; ++n) _Pragma("unroll") for (int k = 0; k < 2; ++k) dst[n][k] = *(const LAS bf16x8*)(lds + PG8_SB(b, h) + boff + n * 2048 + k * 1024); } while (0)
#define PG8_MMA(ai, bj, At, Bt) do { __builtin_amdgcn_s_setprio(1); _Pragma("unroll") for (int m = 0; m < 4; ++m) _Pragma("unroll") for (int n = 0; n < 2; ++n) _Pragma("unroll") for (int k = 0; k < 2; ++k) \
        acc[ai][bj][m][n] = __builtin_amdgcn_mfma_f32_16x16x32_bf16(Bt[n][k], At[m][k], acc[ai][bj][m][n], 0, 0, 0); __builtin_amdgcn_s_setprio(0); } while (0)
#define PG8_WAIT_V(n) asm volatile("s_waitcnt vmcnt(" #n ")" ::: "memory")
#define PG8_WAIT_L(n) asm volatile("s_waitcnt lgkmcnt(" #n ")" ::: "memory")
#define PG8_BAR __builtin_amdgcn_s_barrier()
#define PG8_SCHED __builtin_amdgcn_sched_barrier(0)
#define PG8_VOFF(VO, U) do { _Pragma("unroll") for (int _h = 0; _h < 2; ++_h) _Pragma("unroll") for (int _i = 0; _i < 2; ++_i) (VO)[_h][_i] = S.a_row_off(U, _h * HALF + RA[_i]) + (unsigned)CA[_i]; } while (0)
    Unit cur, nxt; int ui = 0;
    if (!S.next(0, cur)) return;
    f32x4 acc[2][2][4][2];
#pragma unroll
    for (int a = 0; a < 2; ++a)
#pragma unroll
        for (int b = 0; b < 2; ++b)
#pragma unroll
            for (int m = 0; m < 4; ++m)
#pragma unroll
                for (int n = 0; n < 2; ++n) acc[a][b][m][n] = (f32x4){0.f, 0.f, 0.f, 0.f};
    bf16x8 At[4][2], B0[2][2], B1[2][2];
    unsigned voA[2][2], voN[2][2];
    PG8_VOFF(voA, cur);
    E.prep(cur, 0, lds);
    {
        const char* b0 = S.b_tile(cur, 0); const char* b1 = S.b_tile(cur, 1);
        PG8_STAGE_B(PG8_SB(0, 0), b0, 0); PG8_STAGE_B(PG8_SB(0, 1), b0, 1); PG8_STAGE_A(PG8_SA(0, 0), voA, 0, 0); PG8_STAGE_A(PG8_SA(0, 1), voA, 1, 0);
        if (wr == 1) PG8_BAR;
        PG8_WAIT_V(2); PG8_BAR;
        PG8_STAGE_B(PG8_SB(1, 0), b1, 0); PG8_STAGE_A(PG8_SA(1, 0), voA, 0, 1); PG8_STAGE_B(PG8_SB(1, 1), b1, 1);
        PG8_WAIT_V(6); PG8_BAR;
    }
    for (;;) {
        const bool has_next = S.next(ui + 1, nxt);
        if (has_next) { PG8_VOFF(voN, nxt); E.prep(nxt, ui + 1, lds); }
        else {
#pragma unroll
            for (int _h = 0; _h < 2; ++_h)
#pragma unroll
                for (int _i = 0; _i < 2; ++_i) voN[_h][_i] = voA[_h][_i];
            nxt = cur; }
        for (int t = 0; t < nt; t += 2) {
            const bool last = (t == nt - 2);
            unsigned vo2[2][2];
#pragma unroll
            for (int _h = 0; _h < 2; ++_h)
#pragma unroll
                for (int _i = 0; _i < 2; ++_i) vo2[_h][_i] = last ? voN[_h][_i] : voA[_h][_i];
            const int kt2 = last ? 0 : t + 2, kt3 = kt2 + 1;
            const char* b2 = last ? S.b_tile(nxt, 0) : S.b_tile(cur, t + 2);
            const char* b3 = last ? S.b_tile(nxt, 1) : S.b_tile(cur, t + 3);
            PG8_LDB(B0, 0, 0); PG8_LDB(B1, 0, 1); PG8_SCHED; PG8_LDA(At, 0, 0); PG8_STAGE_A(PG8_SA(1, 1), voA, 1, t + 1);
            PG8_WAIT_V(8); PG8_WAIT_L(0); PG8_BAR; PG8_MMA(0, 0, At, B0); PG8_MMA(0, 1, At, B1); PG8_BAR; PG8_SCHED;
            PG8_LDA(At, 0, 1); PG8_STAGE_B(PG8_SB(0, 0), b2, 0); PG8_STAGE_B(PG8_SB(0, 1), b2, 1); PG8_STAGE_A(PG8_SA(0, 0), vo2, 0, kt2);
            PG8_WAIT_V(8); PG8_WAIT_L(0); PG8_BAR; PG8_MMA(1, 0, At, B0); PG8_MMA(1, 1, At, B1); PG8_BAR; PG8_SCHED;
            PG8_LDB(B0, 1, 0); PG8_LDB(B1, 1, 1); PG8_SCHED; PG8_LDA(At, 1, 0); PG8_STAGE_A(PG8_SA(0, 1), vo2, 1, kt2);
            PG8_WAIT_V(8); PG8_WAIT_L(0); PG8_BAR; PG8_MMA(0, 0, At, B0); PG8_MMA(0, 1, At, B1); PG8_BAR; PG8_SCHED;
            PG8_LDA(At, 1, 1); PG8_STAGE_B(PG8_SB(1, 0), b3, 0); PG8_STAGE_B(PG8_SB(1, 1), b3, 1); PG8_STAGE_A(PG8_SA(1, 0), vo2, 0, kt3);
            PG8_WAIT_V(8); PG8_WAIT_L(0); PG8_BAR; PG8_MMA(1, 0, At, B0); PG8_MMA(1, 1, At, B1); PG8_BAR; PG8_SCHED;
        }
        if constexpr (ALIGN_EPI) { if (wr == 0) PG8_BAR; }
        E(acc, cur, ui, wr, wc, fr, fq, lds);
        if (!has_next) break;
#pragma unroll
        for (int a = 0; a < 2; ++a)
#pragma unroll
            for (int b = 0; b < 2; ++b)
#pragma unroll
                for (int m = 0; m < 4; ++m)
#pragma unroll
                    for (int n = 0; n < 2; ++n) acc[a][b][m][n] = (f32x4){0.f, 0.f, 0.f, 0.f};
        cur = nxt; ++ui;
#pragma unroll
        for (int _h = 0; _h < 2; ++_h)
#pragma unroll
            for (int _i = 0; _i < 2; ++_i) voA[_h][_i] = voN[_h][_i];
        if constexpr (ALIGN_EPI) { if (wr == 1) PG8_BAR; }
    }
    PG8_WAIT_V(0);
    if constexpr (!ALIGN_EPI) { if (wr == 0) PG8_BAR; }
    PG8_BAR;
#undef PG8_SA
#undef PG8_SB
#undef PG8_GLDS
#undef PG8_STAGE_A
#undef PG8_STAGE_B
#undef PG8_LDA
#undef PG8_LDB
#undef PG8_MMA
#undef PG8_WAIT_V
#undef PG8_WAIT_L
#undef PG8_BAR
#undef PG8_SCHED
#undef PG8_VOFF
}
}

struct Args {
    const float* in[30]; const int* positions; float* out; unsigned char* ws; int ph_lo, ph_hi;
};
struct Frame {
    LAS unsigned char* lds; volatile LAS unsigned* MISC; gu32* ctl;
    int tid, lane, wave, wg, G;
};

__device__ __forceinline__ void tr_item(const float* src, int ldsrc, int k0, int n0, const float* gk, bf16* dst, int ldd, LAS float* scr, int lane) {
#pragma unroll 8
    for (int i = 0; i < 32; ++i) { const int kk = 2 * i + (lane >> 5); float v = src[(size_t)(k0 + kk) * ldsrc + n0 + (lane & 31)]; if (gk) v *= gk[k0 + kk]; scr[kk * 33 + (lane & 31)] = v; }
    LDS_WAIT(); asm volatile("" ::: "memory");
    const int c = lane & 7;
#pragma unroll
    for (int j = 0; j < 4; ++j) { const int n = (lane >> 3) + 8 * j; const LAS float* s = scr + (8 * c) * 33 + n;
        u32x4 o; o.x = pk2(s[0 * 33], s[1 * 33]); o.y = pk2(s[2 * 33], s[3 * 33]); o.z = pk2(s[4 * 33], s[5 * 33]); o.w = pk2(s[6 * 33], s[7 * 33]);
        *(GAS u32x4*)(dst + (size_t)n * ldd + k0 + 8 * c) = o; }
    LDS_WAIT(); asm volatile("" ::: "memory");
}

__device__ __forceinline__ void p0_prologue(Frame& F, const Args& a) {
    unsigned char* ws = a.ws;
    const float* c_in = a.in[1]; const float* rel_bias = a.in[3]; const float* w_ada = a.in[4]; const float* b_ada = a.in[5];
    float* mod = (float*)(ws + WS_MOD); float* scal = (float*)(ws + WS_SCAL); float* btab = scal + 64; int* tilemax = (int*)(scal + 64 + 1088);
    {
        LAS float* sc = (LAS float*)F.lds;
        LAS float* red = (LAS float*)(F.lds + 16384);
        for (int i = F.tid; i < 4096; i += 512) { const float v = c_in[i]; sc[i] = v / (1.f + __expf(-v)); }
        __syncthreads();
        for (int cb = F.wg; cb < 256; cb += F.G) {
            if (F.tid < 384) {
                const int kg = F.tid / 24, col = F.tid % 24, j = cb * 24 + col;
                float a0 = 0.f, a1 = 0.f, a2 = 0.f, a3 = 0.f;
#pragma unroll 8
                for (int kk = 0; kk < 64; ++kk) { const int k = kg * 64 + kk; const float w = w_ada[(size_t)k * 6144 + j];
                    a0 += sc[k] * w; a1 += sc[1024 + k] * w; a2 += sc[2048 + k] * w; a3 += sc[3072 + k] * w; }
                LAS float* r = red + (kg * 24 + col) * 4; r[0] = a0; r[1] = a1; r[2] = a2; r[3] = a3;
            }
            __syncthreads();
            if (F.tid < 96) { const int col = F.tid >> 2, b = F.tid & 3, j = cb * 24 + col; float s = 0.f;
#pragma unroll
                for (int kg = 0; kg < 16; ++kg) s += red[(kg * 24 + col) * 4 + b];
                __hip_atomic_store(mod + b * 6144 + j, s + b_ada[j], __ATOMIC_RELAXED, __HIP_MEMORY_SCOPE_AGENT); }
            __syncthreads();
        }
    }
    if (F.wg == 0) {
        if (F.tid < 64) {
            const float s1 = wave_sum(a.in[16][F.tid] * a.in[17][F.tid]);
            const float s2 = wave_sum(a.in[18][F.tid] * a.in[19][F.tid]);
            if (F.tid == 0) scal[0] = expf(s1) - expf(s2) + 0.2f;
        }
        for (int i = F.tid; i < 4 * 257; i += 512) {
            const int h = i / 257, rel = (i % 257) - 128; const int n = rel < 0 ? -rel : rel; int bk;
            if (n < 8) bk = n; else { const int lg = 31 - __clz(n * n); bk = 8 + lg - 6; if (bk > 15) bk = 15; }
            if (rel > 0) bk += 16;
            btab[i] = (rel_bias[bk * 4 + h] - rel_bias[15 * 4 + h]) * LOG2E;
        }
    }
    if (F.wg == 1 % F.G) {
        for (int i = F.tid; i < 256; i += 512) { int mx = -2147483647 - 1; for (int k = 0; k < 64; ++k) { const int p = a.positions[i * 64 + k]; mx = p > mx ? p : mx; } tilemax[i] = mx; }
    }
    {
        float* cs = (float*)(ws + WS_CS);
        for (int idx = F.wg * 512 + F.tid; idx < T * 16; idx += F.G * 512) {
            const int t = idx >> 4, i = idx & 15;
            double f = (i & 3) == 0 ? 1.0 : (i & 3) == 1 ? 0.5623413251903491 : (i & 3) == 2 ? 0.31622776601683794 : 0.1778279410038923;
            const int q = i >> 2; f = q == 0 ? f : q == 1 ? f * 0.1 : q == 2 ? f * 0.01 : f * 0.001;
            const double ang = (double)a.positions[t] * f;
            const double k = rint(ang * 0.6366197723675814);
            double r = fma(-k, 1.5707963267948966, ang); r = fma(-k, 6.123233995736766e-17, r);
            const double r2 = r * r;
            const double sn = r * (1.0 + r2 * (-1.0 / 6 + r2 * (1.0 / 120 + r2 * (-1.0 / 5040 + r2 * (1.0 / 362880 + r2 * (-1.0 / 39916800 + r2 * (1.0 / 6227020800.0)))))));
            const double cn = 1.0 + r2 * (-0.5 + r2 * (1.0 / 24 + r2 * (-1.0 / 720 + r2 * (1.0 / 40320 + r2 * (-1.0 / 3628800 + r2 * (1.0 / 479001600.0 + r2 * (-1.0 / 87178291200.0)))))));
            const int qd = (int)((long long)k & 3);
            const double cv = qd == 0 ? cn : qd == 1 ? -sn : qd == 2 ? -cn : sn;
            const double sv = qd == 0 ? sn : qd == 1 ? cn : qd == 2 ? -sn : -cn;
            cs[(size_t)t * 32 + i] = (float)cv; cs[(size_t)t * 32 + 16 + i] = (float)sv;
        }
    }
    {
        u32x4* z = (u32x4*)(ws + WS_WIN + (size_t)672 * 1024 * 2);
        for (int i = F.wg * 512 + F.tid; i < 96 * 1024 * 2 / 16; i += F.G * 512) z[i] = (u32x4){0u, 0u, 0u, 0u};
    }
    __syncthreads();
    {
        LAS float* scr = (LAS float*)(F.lds + F.wave * 16384);
        const int gw = F.wg * NWAVES + F.wave, NGW = F.G * NWAVES;
        constexpr int I_IN = 16 * 69, I_UQ = 6 * 24, I_UKV = 4 * 32, I_O = 16 * 32;
#if STEP >= 6
        constexpr int I_G = 16 * 16 * 16, I_D = 16 * 8 * 32;
#else
        constexpr int I_G = 0, I_D = 0;
#endif
        constexpr int NITEMS = I_IN + I_UQ + I_UKV + I_O + 2 * I_G + I_D;
        for (int it = gw; it < NITEMS; it += NGW) {
            int r = it;
            if (r < I_IN) { const int kb = r / 69, nb = r % 69, n0 = nb * 32, dn = n0 < 672 ? n0 : n0 + 96;
                tr_item(a.in[7], 2208, kb * 64, n0, nullptr, (bf16*)(ws + WS_WIN) + (size_t)dn * 1024, 1024, scr, F.lane); continue; } r -= I_IN;
            if (r < I_UQ) { const int kb = r / 24, nb = r % 24;
                tr_item(a.in[9], 768, kb * 64, nb * 32, a.in[8], (bf16*)(ws + WS_WUQ) + (size_t)nb * 32 * 384, 384, scr, F.lane); continue; } r -= I_UQ;
            if (r < I_UKV) { const int kb = r / 32, nb = r % 32;
                tr_item(a.in[11], 1024, kb * 64, nb * 32, a.in[10], (bf16*)(ws + WS_WUKV) + (size_t)nb * 32 * 256, 256, scr, F.lane); continue; } r -= I_UKV;
            if (r < I_O) { const int kb = r / 32, nb = r % 32;
                tr_item(a.in[21], 1024, kb * 64, nb * 32, nullptr, (bf16*)(ws + WS_WO) + (size_t)nb * 32 * 1024, 1024, scr, F.lane); continue; } r -= I_O;
#if STEP >= 6
            if (r < 2 * I_G) { const int up = r >= I_G; if (up) r -= I_G; const int e = r / 256, kb = (r % 256) / 16, nb = r % 16, n0 = nb * 32;
                const float* src = (up ? a.in[28] : a.in[27]) + (size_t)e * 1024 * 512;
                bf16* dst = (bf16*)(ws + WS_WGU) + ((size_t)(e * 4 + (n0 >> 7)) * 256 + (up ? 128 : 0) + (n0 & 127)) * 1024;
                tr_item(src, 512, kb * 64, n0, nullptr, dst, 1024, scr, F.lane); continue; } r -= 2 * I_G;
            { const int e = r / 256, kb = (r % 256) / 32, nb = r % 32;
                tr_item(a.in[29] + (size_t)e * 512 * 1024, 1024, kb * 64, nb * 32, nullptr, (bf16*)(ws + WS_WD) + ((size_t)e * 1024 + nb * 32) * 512, 512, scr, F.lane); }
#endif
        }
    }
}

__device__ __forceinline__ void p1_norm1(Frame& F, const Args& a) {
    const float* x = a.in[0]; const float* g = a.in[6]; const float* mod = (const float*)(a.ws + WS_MOD); bf16* hA = (bf16*)(a.ws + WS_HA);
    const int gw = F.wg * NWAVES + F.wave, NGW = F.G * NWAVES;
    for (int blk = gw; blk < T / 8; blk += NGW) {
        const int b = (blk * 8) / S; const float* mb = mod + b * 6144;
        f32x4 gm[4], sh[4];
#pragma unroll
        for (int j = 0; j < 4; ++j) { const f32x4 gg = ((const f32x4*)g)[F.lane + 64 * j], sc = ((const f32x4*)(mb + 1024))[F.lane + 64 * j]; gm[j] = gg * (sc + 1.0f); sh[j] = ((const f32x4*)mb)[F.lane + 64 * j]; }
        for (int rr = 0; rr < 8; ++rr) {
            const size_t row = (size_t)blk * 8 + rr;
            const GAS f32x4* xr = (const GAS f32x4*)(x + row * D) + F.lane;
            f32x4 v[4]; float s = 0.f;
#pragma unroll
            for (int j = 0; j < 4; ++j) { v[j] = xr[64 * j]; s += (v[j].x * v[j].x + v[j].y * v[j].y) + (v[j].z * v[j].z + v[j].w * v[j].w); }
            const float rs = rsqrtf(wave_sum(s) * (1.f / D) + EPS);
            GAS unsigned long long* o8 = (GAS unsigned long long*)(hA + row * D) + F.lane;
#pragma unroll
            for (int j = 0; j < 4; ++j) { const f32x4 o = v[j] * rs * gm[j] + sh[j];
                o8[64 * j] = (unsigned long long)pk2(o.x, o.y) | ((unsigned long long)pk2(o.z, o.w) << 32); }
        }
    }
}

__device__ __forceinline__ unsigned bfpair(float lo, float hi) { return pk2(lo, hi); }
__device__ __forceinline__ void p3b_prep(Frame& F, const Args& a) {
    unsigned char* ws = a.ws;
    bf16* qraw = (bf16*)(ws + WS_QRAW); const bf16* kvraw = (const bf16*)(ws + WS_KVRAW); bf16* proj = (bf16*)(ws + WS_PROJ); bf16* KM = (bf16*)(ws + WS_KM);
    const float* cs = (const float*)(ws + WS_CS);
    const float* mq_g = a.in[12]; const float* mk_g = a.in[13]; const float* dq_g = a.in[14]; const float* dk_g = a.in[15];
    const int lane = F.lane, h = lane >> 3, s8 = lane & 7;
    const int gw = F.wg * NWAVES + F.wave, NGW = F.G * NWAVES;
    float gq[12], gk[12], gdq[8], gdk[8];
#pragma unroll
    for (int j = 0; j < 8; ++j) { gq[j] = mq_g[8 * s8 + j]; gk[j] = mk_g[8 * s8 + j]; gdq[j] = dq_g[8 * s8 + j]; gdk[j] = dk_g[8 * s8 + j]; }
    gq[8] = mq_g[64 + 2 * s8]; gq[9] = mq_g[65 + 2 * s8]; gq[10] = mq_g[80 + 2 * s8]; gq[11] = mq_g[81 + 2 * s8];
    gk[8] = mk_g[64 + 2 * s8]; gk[9] = mk_g[65 + 2 * s8]; gk[10] = mk_g[80 + 2 * s8]; gk[11] = mk_g[81 + 2 * s8];
    const float qsc = 0.10206207261596577f * LOG2E, dsc = 0.125f * LOG2E;
    for (int t = gw; t < T; t += NGW) {
        const float c0 = cs[(size_t)t * 32 + 2 * s8], c1 = cs[(size_t)t * 32 + 2 * s8 + 1], n0 = cs[(size_t)t * 32 + 16 + 2 * s8], n1 = cs[(size_t)t * 32 + 17 + 2 * s8];
        {
            bf16* qp = qraw + (size_t)t * 768 + h * 96;
            const u32x4 v = *(const u32x4*)(qp + 8 * s8); const unsigned r1 = *(const unsigned*)(qp + 64 + 2 * s8), r2 = *(const unsigned*)(qp + 80 + 2 * s8);
            float x[12];
#pragma unroll
            for (int e = 0; e < 4; ++e) { x[2 * e] = __builtin_bit_cast(float, v[e] << 16); x[2 * e + 1] = __builtin_bit_cast(float, v[e] & 0xffff0000u); }
            x[8] = __builtin_bit_cast(float, r1 << 16); x[9] = __builtin_bit_cast(float, r1 & 0xffff0000u); x[10] = __builtin_bit_cast(float, r2 << 16); x[11] = __builtin_bit_cast(float, r2 & 0xffff0000u);
            float ss = 0.f;
#pragma unroll
            for (int j = 0; j < 12; ++j) ss += x[j] * x[j];
            ss += __shfl_xor(ss, 1); ss += __shfl_xor(ss, 2); ss += __shfl_xor(ss, 4);
            const float rs = rsqrtf(ss * (1.f / 96.f) + EPS) * qsc;
#pragma unroll
            for (int j = 0; j < 12; ++j) x[j] *= rs * gq[j];
            u32x4 o; o.x = pk2(x[0], x[1]); o.y = pk2(x[2], x[3]); o.z = pk2(x[4], x[5]); o.w = pk2(x[6], x[7]);
            *(u32x4*)(qp + 8 * s8) = o;
            *(unsigned*)(qp + 64 + 2 * s8) = pk2(x[8] * c0 - x[10] * n0, x[9] * c1 - x[11] * n1);
            *(unsigned*)(qp + 80 + 2 * s8) = pk2(x[10] * c0 + x[8] * n0, x[11] * c1 + x[9] * n1);
        }
        {
            const bf16* kp = kvraw + (size_t)t * 1024 + h * 128; const bf16* pp = proj + (size_t)t * PW + P_KPE;
            const u32x4 v = *(const u32x4*)(kp + 8 * s8); const unsigned r1 = *(const unsigned*)(pp + 2 * s8), r2 = *(const unsigned*)(pp + 16 + 2 * s8);
            float x[12];
#pragma unroll
            for (int e = 0; e < 4; ++e) { x[2 * e] = __builtin_bit_cast(float, v[e] << 16); x[2 * e + 1] = __builtin_bit_cast(float, v[e] & 0xffff0000u); }
            x[8] = __builtin_bit_cast(float, r1 << 16); x[9] = __builtin_bit_cast(float, r1 & 0xffff0000u); x[10] = __builtin_bit_cast(float, r2 << 16); x[11] = __builtin_bit_cast(float, r2 & 0xffff0000u);
            float ss = 0.f;
#pragma unroll
            for (int j = 0; j < 12; ++j) ss += x[j] * x[j];
            ss += __shfl_xor(ss, 1); ss += __shfl_xor(ss, 2); ss += __shfl_xor(ss, 4);
            const float rs = rsqrtf(ss * (1.f / 96.f) + EPS);
#pragma unroll
            for (int j = 0; j < 12; ++j) x[j] *= rs * gk[j];
            bf16* op = KM + (size_t)t * 768 + h * 96;
            u32x4 o; o.x = pk2(x[0], x[1]); o.y = pk2(x[2], x[3]); o.z = pk2(x[4], x[5]); o.w = pk2(x[6], x[7]);
            *(u32x4*)(op + 8 * s8) = o;
            *(unsigned*)(op + 64 + 2 * s8) = pk2(x[8] * c0 - x[10] * n0, x[9] * c1 - x[11] * n1);
            *(unsigned*)(op + 80 + 2 * s8) = pk2(x[10] * c0 + x[8] * n0, x[11] * c1 + x[9] * n1);
        }
#pragma unroll
        for (int qk = 0; qk < 2; ++qk) {
            bf16* dp = proj + (size_t)t * PW + (qk == 0 ? P_DQ : P_DK) + lane * 8;
            const u32x4 v = *(const u32x4*)dp;
            float x[8];
#pragma unroll
            for (int e = 0; e < 4; ++e) { x[2 * e] = __builtin_bit_cast(float, v[e] << 16); x[2 * e + 1] = __builtin_bit_cast(float, v[e] & 0xffff0000u); }
            float ss = 0.f;
#pragma unroll
            for (int j = 0; j < 8; ++j) ss += x[j] * x[j];
            ss += __shfl_xor(ss, 1); ss += __shfl_xor(ss, 2); ss += __shfl_xor(ss, 4);
            const float rs = rsqrtf(ss * (1.f / 64.f) + EPS) * (qk == 0 ? dsc : 1.0f);
#pragma unroll
            for (int j = 0; j < 8; ++j) x[j] *= rs * (qk == 0 ? gdq[j] : gdk[j]);
            u32x4 o; o.x = pk2(x[0], x[1]); o.y = pk2(x[2], x[3]); o.z = pk2(x[4], x[5]); o.w = pk2(x[6], x[7]);
            *(u32x4*)dp = o;
        }
    }
}

namespace att {
typedef short v4i16_t __attribute__((ext_vector_type(4)));
typedef float f32x2_t __attribute__((ext_vector_type(2))); typedef __bf16 bf16x2_t __attribute__((ext_vector_type(2)));
__device__ __forceinline__ unsigned cvtpk_s(float lo, float hi) { f32x2_t v = {lo, hi}; bf16x2_t b = __builtin_convertvector(v, bf16x2_t); return __builtin_bit_cast(unsigned, b); }
__device__ __forceinline__ bf16x8 vtr2(const LAS unsigned char* p, int off_hi) {
    const v4i16_t lo = __builtin_amdgcn_ds_read_tr16_b64_v4i16((LAS v4i16_t*)p);
    const v4i16_t hi = __builtin_amdgcn_ds_read_tr16_b64_v4i16((LAS v4i16_t*)(p + off_hi));
    return (bf16x8){lo[0], lo[1], lo[2], lo[3], hi[0], hi[1], hi[2], hi[3]};
}
constexpr float THR = 8.0f;

template <bool DIFF>
__device__ __forceinline__ void attn_unit(LAS unsigned char* lds, const Args& a, int b, int h, int qt, float lam) {
    constexpr int DQK = DIFF ? 64 : 96, DV = DIFF ? 128 : 64, KW = DIFF ? 128 : 96;
    constexpr int KRS = KW * 2 + 16, VRS = DV * 2 + 64;
    constexpr int OFF_K = 0, OFF_V = 2 * 64 * KRS, OFF_KPOS = OFF_V + 2 * 64 * VRS, OFF_BT = OFF_KPOS + 512, OFF_WSF = OFF_BT + 1040;
    static_assert(OFF_WSF + 8 * 256 <= RING_BYTES, "attention LDS");
    constexpr int QROWS = DIFF ? 128 : 256, NKP = KW * 2 / 16, NVP = DV * 2 / 16, ND = DQK / 16, NBLK = DV / 32;
    const int tid = threadIdx.x, lane = tid & 63, wid = __builtin_amdgcn_readfirstlane(tid >> 6), r32 = lane & 31, hi = lane >> 5;
    const int wq = DIFF ? (wid & 3) : wid, msub = DIFF ? (wid >> 2) : 0;
    const int q0 = qt * QROWS, NT = (q0 + QROWS) / 64, cw = (q0 + 32 * wq) / 64;
    const size_t tok0 = (size_t)b * S;
    unsigned char* ws = a.ws;
    const bf16* Qg; const unsigned char* Kg; const unsigned char* Vg; size_t kpitch, vpitch; int qpitch;
    if (DIFF) { const bf16* proj = (const bf16*)(ws + WS_PROJ);
        Qg = proj + tok0 * PW + P_DQ + h * 128 + msub * 64; qpitch = PW;
        Kg = (const unsigned char*)(proj + tok0 * PW + P_DK + h * 128); kpitch = PW * 2;
        Vg = (const unsigned char*)(proj + tok0 * PW + P_DV + h * 128); vpitch = PW * 2;
    } else {
        Qg = (const bf16*)(ws + WS_QRAW) + tok0 * 768 + h * 96; qpitch = 768;
        Kg = (const unsigned char*)((const bf16*)(ws + WS_KM) + tok0 * 768 + h * 96); kpitch = 768 * 2;
        Vg = (const unsigned char*)((const bf16*)(ws + WS_KVRAW) + tok0 * 1024 + h * 128 + 64); vpitch = 1024 * 2;
    }
    const int kp0 = tid, kp1 = tid + 512; const bool k1on = kp1 < 64 * NKP;
    const int kr0 = kp0 / NKP, kc0 = kp0 % NKP, kr1 = k1on ? kp1 / NKP : 0, kc1 = k1on ? kp1 % NKP : 0;
    const int vp0 = tid, vp1 = tid + 512; const bool v1on = vp1 < 64 * NVP;
    const int vr0 = vp0 / NVP, vc0 = vp0 % NVP, vr1 = v1on ? vp1 / NVP : 0, vc1 = v1on ? vp1 % NVP : 0;
    const size_t kg0 = (size_t)kr0 * kpitch + kc0 * 16, kg1 = (size_t)kr1 * kpitch + kc1 * 16, vg0 = (size_t)vr0 * vpitch + vc0 * 16, vg1 = (size_t)vr1 * vpitch + vc1 * 16;
    const int kl0 = OFF_K + kr0 * KRS + kc0 * 16, kl1 = OFF_K + kr1 * KRS + kc1 * 16, vl0 = OFF_V + vr0 * VRS + vc0 * 16, vl1 = OFF_V + vr1 * VRS + vc1 * 16;
    u32x4 sk0 = {0u, 0u, 0u, 0u}, sk1 = {0u, 0u, 0u, 0u}, sv0 = {0u, 0u, 0u, 0u}, sv1 = {0u, 0u, 0u, 0u}; int skp = 0;
#define ATT_LOAD(t) do { const size_t ko_ = (size_t)(t) * 64 * kpitch, vo_ = (size_t)(t) * 64 * vpitch; \
        sk0 = *(const u32x4*)(Kg + ko_ + kg0); if (k1on) sk1 = *(const u32x4*)(Kg + ko_ + kg1); \
        sv0 = *(const u32x4*)(Vg + vo_ + vg0); if (v1on) sv1 = *(const u32x4*)(Vg + vo_ + vg1); \
        if (DIFF && tid < 64) skp = a.positions[tok0 + (size_t)(t) * 64 + tid]; } while (0)
#define ATT_WRITE(buf) do { *(LAS u32x4*)(lds + (buf) * 64 * KRS + kl0) = sk0; if (k1on) *(LAS u32x4*)(lds + (buf) * 64 * KRS + kl1) = sk1; \
        *(LAS u32x4*)(lds + (buf) * 64 * VRS + vl0) = sv0; if (v1on) *(LAS u32x4*)(lds + (buf) * 64 * VRS + vl1) = sv1; \
        if (DIFF && tid < 64) *(LAS int*)(lds + OFF_KPOS + (buf) * 256 + tid * 4) = skp; } while (0)
    ATT_LOAD(0);
    bf16x8 qf[ND];
    { const bf16* qrow = Qg + (size_t)(q0 + 32 * wq + r32) * qpitch + 8 * hi;
#pragma unroll
      for (int d0 = 0; d0 < ND; ++d0) qf[d0] = *(const bf16x8*)(qrow + 16 * d0); }
    int qp = 0, qmin = 0;
    if (DIFF) {
        qp = a.positions[tok0 + q0 + 32 * wq + r32];
        int mn = qp;
#pragma unroll
        for (int o = 1; o < 64; o <<= 1) { const int x = __shfl_xor(mn, o); mn = x < mn ? x : mn; }
        qmin = __builtin_amdgcn_readfirstlane(mn);
        const float* btab = (const float*)(ws + WS_SCAL) + 64 + h * 257;
        if (tid < 257) *(LAS float*)(lds + OFF_BT + tid * 4) = btab[tid];
    }
    ATT_WRITE(0);
    __syncthreads();
    LAS float* wsf = (LAS float*)(lds + OFF_WSF + wid * 256);
    const int kfa = OFF_K + r32 * KRS + 16 * hi + msub * 128;
    const int vfa = OFF_V + (4 * hi + ((lane & 15) >> 2)) * VRS + (16 * ((lane >> 4) & 1) + 4 * (lane & 3)) * 2;
    f32x16 o[NBLK];
#pragma unroll
    for (int i = 0; i < NBLK; ++i)
#pragma unroll
        for (int r = 0; r < 16; ++r) o[i][r] = 0.f;
    f32x16 negm;
#pragma unroll
    for (int r = 0; r < 16; ++r) negm[r] = 0.f;
    float mhat = 0.f, lsum = 0.f;
    const int* tilemax = (const int*)((const float*)(ws + WS_SCAL) + 64 + 1088) + b * 64;
    for (int t = 0; t < NT; ++t) {
        const int buf = t & 1;
        if (t + 1 < NT) ATT_LOAD(t + 1);
        if (t <= cw) {
            const LAS unsigned char* kb = lds + buf * 64 * KRS + kfa;
            f32x16 p0 = negm, p1 = negm;
#pragma unroll
            for (int d0 = 0; d0 < ND; ++d0) {
                const bf16x8 k0 = *(const LAS bf16x8*)(kb + d0 * 32), k1 = *(const LAS bf16x8*)(kb + 32 * KRS + d0 * 32);
                p0 = __builtin_amdgcn_mfma_f32_32x32x16_bf16(k0, qf[d0], p0, 0, 0, 0);
                p1 = __builtin_amdgcn_mfma_f32_32x32x16_bf16(k1, qf[d0], p1, 0, 0, 0);
            }
            if (DIFF) {
                const int tmx = tilemax[t];
                if (tmx - qmin > -128) {
                    const LAS unsigned char* kpp = lds + OFF_KPOS + buf * 256 + 16 * hi;
                    const LAS float* bt = (const LAS float*)(lds + OFF_BT);
#pragma unroll
                    for (int g = 0; g < 4; ++g) {
                        const u32x4 ka = *(const LAS u32x4*)(kpp + g * 32), kb2 = *(const LAS u32x4*)(kpp + 128 + g * 32);
#pragma unroll
                        for (int j = 0; j < 4; ++j) {
                            int r0 = (int)ka[j] - qp; r0 = r0 < -128 ? -128 : (r0 > 128 ? 128 : r0);
                            int r1 = (int)kb2[j] - qp; r1 = r1 < -128 ? -128 : (r1 > 128 ? 128 : r1);
                            p0[4 * g + j] += bt[r0 + 128]; p1[4 * g + j] += bt[r1 + 128];
                        }
                    }
                }
            }
            float mx = fmaxf(p0[0], p1[0]);
#pragma unroll
            for (int r = 1; r < 16; ++r) mx = fmaxf(mx, fmaxf(p0[r], p1[r]));
            mx = fmaxf(mx, __shfl_xor(mx, 32));
            if (__any(mx > THR)) {
                const float dl = fmaxf(mx, 0.f);
                mhat += dl;
#pragma unroll
                for (int r = 0; r < 16; ++r) { p0[r] -= dl; p1[r] -= dl; negm[r] = -mhat; }
                const float f = __builtin_amdgcn_exp2f(-dl);
                lsum *= f;
                if (hi == 0) wsf[r32] = f;
                LDS_WAIT();
#pragma unroll
                for (int g = 0; g < 4; ++g) { const f32x4 f4 = *(const LAS f32x4*)(wsf + 8 * g + 4 * hi);
#pragma unroll
                    for (int i = 0; i < NBLK; ++i)
#pragma unroll
                        for (int j = 0; j < 4; ++j) o[i][4 * g + j] *= f4[j]; }
            }
            float sacc = 0.f;
#pragma unroll
            for (int r = 0; r < 16; ++r) { p0[r] = __builtin_amdgcn_exp2f(p0[r]); p1[r] = __builtin_amdgcn_exp2f(p1[r]); sacc += p0[r] + p1[r]; }
            lsum += sacc;
            u32x4 pw[4];
#pragma unroll
            for (int e = 0; e < 4; ++e) { pw[0][e] = cvtpk_s(p0[2 * e], p0[2 * e + 1]); pw[1][e] = cvtpk_s(p0[8 + 2 * e], p0[9 + 2 * e]);
                                          pw[2][e] = cvtpk_s(p1[2 * e], p1[2 * e + 1]); pw[3][e] = cvtpk_s(p1[8 + 2 * e], p1[9 + 2 * e]); }
            const LAS unsigned char* vb = lds + buf * 64 * VRS + vfa;
#pragma unroll
            for (int i = 0; i < NBLK; ++i)
#pragma unroll
                for (int ks = 0; ks < 4; ++ks) {
                    const bf16x8 vf = vtr2(vb + ks * 16 * VRS + i * 64, 8 * VRS);
                    o[i] = __builtin_amdgcn_mfma_f32_32x32x16_bf16(__builtin_bit_cast(bf16x8, pw[ks]), vf, o[i], 0, 0, 0);
                }
        }
        if (t + 1 < NT) ATT_WRITE(buf ^ 1);
        __syncthreads();
    }
#undef ATT_LOAD
#undef ATT_WRITE
    lsum += __shfl_xor(lsum, 32);
    if (hi == 0) wsf[r32] = 1.0f / lsum;
    LDS_WAIT();
#pragma unroll
    for (int g = 0; g < 4; ++g) { const f32x4 f4 = *(const LAS f32x4*)(wsf + 8 * g + 4 * hi);
#pragma unroll
        for (int i = 0; i < NBLK; ++i)
#pragma unroll
            for (int j = 0; j < 4; ++j) o[i][4 * g + j] *= f4[j]; }
    bf16* Ocat = (bf16*)(ws + WS_HA);
    if (!DIFF) {
        LAS bf16* stg = (LAS bf16*)(lds + wid * 4096);
#pragma unroll
        for (int r = 0; r < 16; ++r) { const int orow = (r & 3) + 8 * (r >> 2) + 4 * hi;
#pragma unroll
            for (int i = 0; i < NBLK; ++i) stg[orow * 64 + i * 32 + r32] = (bf16)f2bf(o[i][r]); }
        LDS_WAIT();
        bf16* Ow = Ocat + (tok0 + q0 + 32 * wid) * 1024 + h * 64;
#pragma unroll
        for (int i = 0; i < 4; ++i) { const int row = i * 8 + (lane >> 3), ch = lane & 7; const u32x4 v = *(const LAS u32x4*)(stg + row * 64 + ch * 8); *(u32x4*)(Ow + (size_t)row * 1024 + ch * 8) = v; }
    } else {
        LAS float* X = (LAS float*)lds;
        if (msub == 1) {
#pragma unroll
            for (int r = 0; r < 16; ++r) { const int orow = 32 * wq + (r & 3) + 8 * (r >> 2) + 4 * hi;
#pragma unroll
                for (int i = 0; i < NBLK; ++i) X[orow * 132 + i * 32 + r32] = lam * o[i][r]; }
        }
        __syncthreads();
        if (msub == 0) {
#pragma unroll
            for (int r = 0; r < 16; ++r) { const int orow = 32 * wq + (r & 3) + 8 * (r >> 2) + 4 * hi;
#pragma unroll
                for (int i = 0; i < NBLK; ++i) { const int ix = orow * 132 + i * 32 + r32; X[ix] = o[i][r] - X[ix]; } }
        }
        __syncthreads();
        const float* sg = a.in[20];
        const int row = tid >> 2, part = tid & 3;
        float v[32]; float ss = 0.f;
#pragma unroll
        for (int c4 = 0; c4 < 8; ++c4) { const f32x4 x4 = *(const LAS f32x4*)(X + row * 132 + part * 32 + c4 * 4); v[4 * c4] = x4[0]; v[4 * c4 + 1] = x4[1]; v[4 * c4 + 2] = x4[2]; v[4 * c4 + 3] = x4[3];
            ss += (x4[0] * x4[0] + x4[1] * x4[1]) + (x4[2] * x4[2] + x4[3] * x4[3]); }
        ss += __shfl_xor(ss, 1); ss += __shfl_xor(ss, 2);
        const float rs = rsqrtf(ss * (1.f / 128.f) + EPS) * 0.8f;
        bf16* Ow = Ocat + (tok0 + q0 + row) * 1024 + 512 + h * 128 + part * 32;
#pragma unroll
        for (int c8 = 0; c8 < 4; ++c8) { u32x4 w;
#pragma unroll
            for (int e = 0; e < 4; ++e) { const int c = c8 * 8 + 2 * e; w[e] = pk2(v[c] * rs * sg[part * 32 + c], v[c + 1] * rs * sg[part * 32 + c + 1]); }
            *(u32x4*)(Ow + c8 * 8) = w; }
    }
    __syncthreads();
}

__device__ __forceinline__ void attn_phase(Frame& F, const Args& a) {
    LAS int* slot = (LAS int*)(F.lds + LDSCTL_OFF + 64);
    const float lam = ((const float*)(a.ws + WS_SCAL))[0];
    for (;;) {
        if (F.tid == 0) *slot = (int)__hip_atomic_fetch_add((unsigned*)(F.ctl + CW_QUEUE), 1u, __ATOMIC_RELAXED, __HIP_MEMORY_SCOPE_AGENT);
        __syncthreads();
        const int i = __builtin_amdgcn_readfirstlane(*slot);
        __syncthreads();
        if (i >= 512) break;
        attn_unit<false>(F.lds, a, (i & 31) >> 3, i & 7, 15 - (i >> 5), lam);
    }
    for (;;) {
        if (F.tid == 0) *slot = (int)__hip_atomic_fetch_add((unsigned*)(F.ctl + CW_QUEUE + 64), 1u, __ATOMIC_RELAXED, __HIP_MEMORY_SCOPE_AGENT);
        __syncthreads();
        const int i = __builtin_amdgcn_readfirstlane(*slot);
        __syncthreads();
        if (i >= 512) break;
        attn_unit<true>(F.lds, a, (i & 15) >> 2, i & 3, 31 - (i >> 4), lam);
    }
}
}

__device__ __forceinline__ void p6_norm2_route(Frame& F, const Args& a) {
    unsigned char* ws = a.ws;
    const float* x1 = a.out; const float* g = a.in[22]; const float* mod = (const float*)(ws + WS_MOD); bf16* H2 = (bf16*)(ws + WS_H2);
    const float* w_rg = a.in[23]; const float* b_rg = a.in[24]; const float* w_re = a.in[25]; const float* b_re = a.in[26];
    int* list = (int*)(ws + WS_LIST); float* wl = (float*)(ws + WS_WL);
    LAS float* WT = (LAS float*)F.lds;
    for (int i = F.tid; i < 20480; i += 512) { const int o = i >> 10, k = i & 1023; WT[i] = o < 4 ? w_rg[k * 4 + o] : w_re[k * 16 + (o - 4)]; }
    __syncthreads();
    const int gw = F.wg * NWAVES + F.wave, NGW = F.G * NWAVES;
    for (int blk = gw; blk < T / 8; blk += NGW) {
        const int b = (blk * 8) / S; const float* mb = mod + b * 6144;
        f32x4 gm[4], sh[4];
#pragma unroll
        for (int j = 0; j < 4; ++j) { const f32x4 gg = ((const f32x4*)g)[F.lane + 64 * j], sc = ((const f32x4*)(mb + 4096))[F.lane + 64 * j]; gm[j] = gg * (sc + 1.0f); sh[j] = ((const f32x4*)(mb + 3072))[F.lane + 64 * j]; }
#pragma unroll 1
        for (int rr = 0; rr < 8; ++rr) {
            const int t = blk * 8 + rr;
            const GAS f32x4* xr = (const GAS f32x4*)(x1 + (size_t)t * D) + F.lane;
            f32x4 v[4]; float s = 0.f;
#pragma unroll
            for (int j = 0; j < 4; ++j) { v[j] = xr[64 * j]; s += (v[j].x * v[j].x + v[j].y * v[j].y) + (v[j].z * v[j].z + v[j].w * v[j].w); }
            const float rs = rsqrtf(wave_sum(s) * (1.f / D) + EPS);
            GAS unsigned long long* o8 = (GAS unsigned long long*)(H2 + (size_t)t * D) + F.lane;
#pragma unroll
            for (int j = 0; j < 4; ++j) { v[j] = v[j] * rs * gm[j] + sh[j];
                o8[64 * j] = (unsigned long long)pk2(v[j].x, v[j].y) | ((unsigned long long)pk2(v[j].z, v[j].w) << 32); }
            float lg[4];
#pragma unroll
            for (int o = 0; o < 4; ++o) { float acc = 0.f;
#pragma unroll
                for (int j = 0; j < 4; ++j) { const f32x4 w4 = *(const LAS f32x4*)(WT + o * 1024 + 4 * F.lane + 256 * j); acc += (v[j].x * w4.x + v[j].y * w4.y) + (v[j].z * w4.z + v[j].w * w4.w); }
                lg[o] = wave_sum(acc) + b_rg[o]; }
            int gi = 0; float gmx = lg[0];
#pragma unroll
            for (int i = 1; i < 4; ++i) if (lg[i] > gmx) { gmx = lg[i]; gi = i; }
            gi = __builtin_amdgcn_readfirstlane(gi);
            float den = 0.f;
#pragma unroll
            for (int i = 0; i < 4; ++i) den += __expf(lg[i] - gmx);
            const float gwt = 1.f / den;
            float e[4];
#pragma unroll
            for (int i = 0; i < 4; ++i) { float acc = 0.f; const LAS float* wrow = WT + (4 + gi * 4 + i) * 1024 + 4 * F.lane;
#pragma unroll
                for (int j = 0; j < 4; ++j) { const f32x4 w4 = *(const LAS f32x4*)(wrow + 256 * j); acc += (v[j].x * w4.x + v[j].y * w4.y) + (v[j].z * w4.z + v[j].w * w4.w); }
                e[i] = wave_sum(acc) + b_re[gi * 4 + i]; }
            int i1 = 0; float v1 = e[0];
#pragma unroll
            for (int i = 1; i < 4; ++i) if (e[i] > v1) { v1 = e[i]; i1 = i; }
            int i2 = -1; float v2 = -INFINITY;
#pragma unroll
            for (int i = 0; i < 4; ++i) if (i != i1 && e[i] > v2) { v2 = e[i]; i2 = i; }
            const float e2 = __expf(v2 - v1);
            const float w1 = gwt / (1.f + e2), w2 = gwt * e2 / (1.f + e2);
            const int ea = i1 < i2 ? i1 : i2, eb = i1 < i2 ? i2 : i1;
            const float wlo = i1 < i2 ? w1 : w2, whi = i1 < i2 ? w2 : w1;
            const int bk = gi * 6 + (ea * (7 - ea)) / 2 + (eb - ea - 1);
            if (F.lane == 0) {
                const unsigned slot = __hip_atomic_fetch_add((unsigned*)(F.ctl + CW_BCNT + 64 * bk), 1u, __ATOMIC_RELAXED, __HIP_MEMORY_SCOPE_AGENT);
                __hip_atomic_store(list + bk * 16384 + slot, t, __ATOMIC_RELAXED, __HIP_MEMORY_SCOPE_AGENT);
                const unsigned long long wpair = (unsigned long long)__builtin_bit_cast(unsigned, wlo) | ((unsigned long long)__builtin_bit_cast(unsigned, whi) << 32);
                __hip_atomic_store((unsigned long long*)wl + ((size_t)bk * 16384 + slot), wpair, __ATOMIC_RELAXED, __HIP_MEMORY_SCOPE_AGENT);
            }
        }
    }
}
__device__ __forceinline__ int moe_table(Frame& F) {
    LAS int* tab = (LAS int*)(F.lds + pg8::MOE_TAB_OFF);
    if (F.tid == 0) { int acc = 0;
        for (int k = 0; k < 24; ++k) { const int n = (int)__hip_atomic_load((unsigned*)(F.ctl + CW_BCNT + 64 * k), __ATOMIC_RELAXED, __HIP_MEMORY_SCOPE_AGENT); tab[k] = acc; tab[32 + k] = n; acc += (n + 255) >> 8; }
        tab[24] = acc; }
    __syncthreads();
    return tab[24];
}

__global__ void __launch_bounds__(NWAVES * 64, 2) mk_fwd(Args args) {
    extern __shared__ __attribute__((aligned(16))) unsigned char lds_raw[];
    Frame F;
    F.lds = (LAS unsigned char*)lds_raw;
    F.MISC = (volatile LAS unsigned*)(F.lds + LDSCTL_OFF);
    F.tid = threadIdx.x; F.lane = F.tid & 63; F.wave = __builtin_amdgcn_readfirstlane(F.tid >> 6);
    F.G = gridDim.x; F.wg = blockIdx.x;
    F.ctl = (gu32*)(args.ws + WS_CTL);
    for (int u = F.tid; u < (LDS_BYTES - LDSCTL_OFF) / 4; u += NWAVES * 64) ((LAS unsigned*)(F.lds + LDSCTL_OFF))[u] = 0u;
    __syncthreads();
    XcdBarrier bar = xcd_barrier_post((unsigned*)(F.ctl + CW_BAR), F.MISC + 8);
    const int lo = args.ph_lo, hi = args.ph_hi;
#define IN(k) (lo <= (k) && (k) < hi)
#define BOTH(k) (IN(k) && IN((k) + 1))
    if (IN(0)) { p0_prologue(F, args); if (BOTH(0)) xcd_barrier(bar); }
    if (IN(1)) { p1_norm1(F, args); if (BOTH(1)) xcd_barrier(bar); }
    if (IN(2)) {
        pg8::DenseSched Sd; Sd.init(T, PW, F.G, F.wg, args.ws + WS_WIN, 1024, 1024);
        pg8::EpiStoreBf16 E{(bf16*)(args.ws + WS_PROJ), PW, false};
        pg8::gemm_phase<pg8::EpiStoreBf16, pg8::DenseSched, true>(F.lds, (const char*)(args.ws + WS_HA), 1024, 1024, Sd, E);
        if (BOTH(2)) xcd_barrier(bar);
    }
#if STEP >= 2
    if (IN(3)) {
        {   pg8::DenseSched Sd; Sd.init(T, 768, F.G, F.wg, args.ws + WS_WUQ, PW, 384);
            pg8::EpiStoreBf16RS E{(bf16*)(args.ws + WS_QRAW), 768, (const bf16*)(args.ws + WS_PROJ) + P_CQ, PW, 384};
            pg8::gemm_phase<pg8::EpiStoreBf16RS, pg8::DenseSched, true>(F.lds, (const char*)((const bf16*)(args.ws + WS_PROJ) + P_CQ), 384, 384, Sd, E); }
        {   pg8::DenseSched Sd; Sd.init(T, 1024, F.G, F.wg, args.ws + WS_WUKV, PW, 256);
            pg8::EpiStoreBf16RS E{(bf16*)(args.ws + WS_KVRAW), 1024, (const bf16*)(args.ws + WS_PROJ) + P_CKV, PW, 256};
            pg8::gemm_phase<pg8::EpiStoreBf16RS, pg8::DenseSched, true>(F.lds, (const char*)((const bf16*)(args.ws + WS_PROJ) + P_CKV), 256, 256, Sd, E); }
        if (BOTH(3)) xcd_barrier(bar);
    }
#endif
#if STEP >= 3
    if (IN(4)) { p3b_prep(F, args); if (BOTH(4)) xcd_barrier(bar); }
#endif
#if STEP >= 4
    if (IN(5)) { att::attn_phase(F, args); if (BOTH(5)) xcd_barrier(bar); }
#endif
#if STEP >= 5
    if (IN(6)) {
        pg8::DenseSched Sd; Sd.init(T, 1024, F.G, F.wg, args.ws + WS_WO, 1024, 1024);
        pg8::EpiResid E{args.in[0], args.out, (const float*)(args.ws + WS_MOD)};
        pg8::gemm_phase<pg8::EpiResid, pg8::DenseSched, true>(F.lds, (const char*)(args.ws + WS_HA), 1024, 1024, Sd, E);
        if (BOTH(6)) xcd_barrier(bar);
    }
#endif
#if STEP >= 6
    if (IN(7)) { p6_norm2_route(F, args); if (BOTH(7)) xcd_barrier(bar); }
    if (IN(8)) {
        const int ntiles = moe_table(F);
        const LAS int* tab = (const LAS int*)(F.lds + pg8::MOE_TAB_OFF);
        pg8::MoeSched Sm{F.G, F.wg, 8, ntiles, tab, (const int*)(args.ws + WS_LIST), (const char*)(args.ws + WS_WGU), 2048u, true, false};
        pg8::EpiSwiglu E{(bf16*)(args.ws + WS_HB), (const float*)(args.ws + WS_WL), tab};
        pg8::gemm_phase<pg8::EpiSwiglu, pg8::MoeSched, true>(F.lds, (const char*)(args.ws + WS_H2), 1024, 1024, Sm, E);
        if (BOTH(8)) xcd_barrier(bar);
    }
    if (IN(9)) {
        const int ntiles = moe_table(F);
        const LAS int* tab = (const LAS int*)(F.lds + pg8::MOE_TAB_OFF);
        pg8::MoeSched Sm{F.G, F.wg, 4, ntiles, tab, (const int*)(args.ws + WS_LIST), (const char*)(args.ws + WS_WD), 2048u, false, true};
        pg8::EpiMoeOut E{args.out, (const float*)(args.ws + WS_MOD), (const int*)(args.ws + WS_LIST), tab};
        pg8::gemm_phase<pg8::EpiMoeOut, pg8::MoeSched, true>(F.lds, (const char*)(args.ws + WS_HB), 512, 1024, Sm, E);
    }
#endif
#undef IN
#undef BOTH
}
#if STEP >= 6
constexpr int N_PHASES = 10;
#elif STEP >= 5
constexpr int N_PHASES = 7;
#elif STEP >= 4
constexpr int N_PHASES = 6;
#elif STEP >= 3
constexpr int N_PHASES = 5;
#elif STEP >= 2
constexpr int N_PHASES = 4;
#else
constexpr int N_PHASES = 3;
#endif

namespace nv {
__device__ __forceinline__ float ldf(const float* p, size_t i) { return p[i]; }
__device__ __forceinline__ float ldf(const bf16* p, size_t i) { return bf2f(p[i]); }
__device__ __forceinline__ float block_sum256(float v, float* sh) {
    v = wave_sum(v);
    if ((threadIdx.x & 63) == 0) sh[threadIdx.x >> 6] = v;
    __syncthreads();
    float r = (sh[0] + sh[1]) + (sh[2] + sh[3]);
    __syncthreads();
    return r;
}
template <typename TA>
__global__ void k_gemm(const TA* A, int lda, const float* Bm, int ldb, float* C, int ldc, int M, int N, int K) {
    __shared__ float As[16][65];
    __shared__ float Bs[16][65];
    int tx = threadIdx.x & 15, ty = threadIdx.x >> 4;
    int m0 = blockIdx.y * 64, n0 = blockIdx.x * 64;
    float acc[4][4];
#pragma unroll
    for (int i = 0; i < 4; ++i)
#pragma unroll
        for (int j = 0; j < 4; ++j) acc[i][j] = 0.f;
    for (int k0 = 0; k0 < K; k0 += 16) {
        for (int i = threadIdx.x; i < 1024; i += 256) { int r = i >> 4, c = i & 15; As[c][r] = ldf(A, (size_t)(m0 + r) * lda + k0 + c); }
        for (int i = threadIdx.x; i < 1024; i += 256) { int r = i >> 6, c = i & 63; Bs[r][c] = (n0 + c < N) ? Bm[(size_t)(k0 + r) * ldb + n0 + c] : 0.f; }
        __syncthreads();
#pragma unroll
        for (int k = 0; k < 16; ++k) {
            float a0 = As[k][ty * 4 + 0], a1 = As[k][ty * 4 + 1], a2 = As[k][ty * 4 + 2], a3 = As[k][ty * 4 + 3];
            float b0 = Bs[k][tx * 4 + 0], b1 = Bs[k][tx * 4 + 1], b2 = Bs[k][tx * 4 + 2], b3 = Bs[k][tx * 4 + 3];
            acc[0][0] += a0 * b0; acc[0][1] += a0 * b1; acc[0][2] += a0 * b2; acc[0][3] += a0 * b3;
            acc[1][0] += a1 * b0; acc[1][1] += a1 * b1; acc[1][2] += a1 * b2; acc[1][3] += a1 * b3;
            acc[2][0] += a2 * b0; acc[2][1] += a2 * b1; acc[2][2] += a2 * b2; acc[2][3] += a2 * b3;
            acc[3][0] += a3 * b0; acc[3][1] += a3 * b1; acc[3][2] += a3 * b2; acc[3][3] += a3 * b3;
        }
        __syncthreads();
    }
#pragma unroll
    for (int i = 0; i < 4; ++i)
#pragma unroll
        for (int j = 0; j < 4; ++j) { int n = n0 + tx * 4 + j; if (n < N) C[(size_t)(m0 + ty * 4 + i) * ldc + n] = acc[i][j]; }
}
template <typename TI>
__global__ void k_rms_seg(const TI* in, int ld, int off, int n, const float* g, float* out) {
    int r = blockIdx.x * 4 + (threadIdx.x >> 6), lane = threadIdx.x & 63;
    size_t base = (size_t)r * ld + off;
    float ss = 0.f;
    for (int d = lane; d < n; d += 64) { float v = ldf(in, base + d); ss += v * v; }
    ss = wave_sum(ss);
    float rs = rsqrtf(ss / (float)n + EPS);
    for (int d = lane; d < n; d += 64) out[(size_t)r * n + d] = ldf(in, base + d) * rs * g[d];
}
template <typename TQ, typename TKV, typename TP>
__global__ void k_prep_mla(const TQ* q_raw, int ldq, const TKV* kv_raw, int ldkv, const TP* kpe, int ldp, const float* cs, const float* q_g, const float* k_g, float* Qm, float* Km) {
    int idx = blockIdx.x * 256 + threadIdx.x;
    int t = idx >> 3, h = idx & 7;
    const float* csr = cs + (size_t)t * 32;
    const float scale = 0.10206207261596577f;
    {
        size_t qb = (size_t)t * ldq + h * 96;
        float ss = 0.f;
        for (int d = 0; d < 96; ++d) { float v = ldf(q_raw, qb + d); ss += v * v; }
        float rs = rsqrtf(ss * (1.f / 96.f) + EPS);
        float* o = Qm + (size_t)t * 768 + h * 96;
        for (int d = 0; d < 64; ++d) o[d] = ldf(q_raw, qb + d) * rs * q_g[d] * scale;
        for (int i = 0; i < 16; ++i) {
            float x1 = ldf(q_raw, qb + 64 + i) * rs * q_g[64 + i], x2 = ldf(q_raw, qb + 80 + i) * rs * q_g[80 + i];
            float c = csr[i], s = csr[16 + i];
            o[64 + i] = (x1 * c - x2 * s) * scale; o[80 + i] = (x2 * c + x1 * s) * scale;
        }
    }
    {
        size_t kb = (size_t)t * ldkv + h * 128, pb = (size_t)t * ldp;
        float ss = 0.f;
        for (int d = 0; d < 64; ++d) { float v = ldf(kv_raw, kb + d); ss += v * v; }
        for (int d = 0; d < 32; ++d) { float v = ldf(kpe, pb + d); ss += v * v; }
        float rs = rsqrtf(ss * (1.f / 96.f) + EPS);
        float* o = Km + (size_t)t * 768 + h * 96;
        for (int d = 0; d < 64; ++d) o[d] = ldf(kv_raw, kb + d) * rs * k_g[d];
        for (int i = 0; i < 16; ++i) {
            float x1 = ldf(kpe, pb + i) * rs * k_g[64 + i], x2 = ldf(kpe, pb + 16 + i) * rs * k_g[80 + i];
            float c = csr[i], s = csr[16 + i];
            o[64 + i] = x1 * c - x2 * s; o[80 + i] = x2 * c + x1 * s;
        }
    }
}
template <typename TP>
__global__ void k_prep_diff(const TP* dq, const TP* dk, int ldp, const float* q_g, const float* k_g, float* Qd, float* Kd) {
    int idx = blockIdx.x * 256 + threadIdx.x;
    int t = idx >> 3, hm = idx & 7;
    {
        size_t b = (size_t)t * ldp + hm * 64; float ss = 0.f;
        for (int d = 0; d < 64; ++d) { float v = ldf(dq, b + d); ss += v * v; }
        float rs = rsqrtf(ss * (1.f / 64.f) + EPS);
        float* o = Qd + (size_t)t * 512 + hm * 64;
        for (int d = 0; d < 64; ++d) o[d] = ldf(dq, b + d) * rs * q_g[d] * 0.125f;
    }
    {
        size_t b = (size_t)t * ldp + hm * 64; float ss = 0.f;
        for (int d = 0; d < 64; ++d) { float v = ldf(dk, b + d); ss += v * v; }
        float rs = rsqrtf(ss * (1.f / 64.f) + EPS);
        float* o = Kd + (size_t)t * 512 + hm * 64;
        for (int d = 0; d < 64; ++d) o[d] = ldf(dk, b + d) * rs * k_g[d];
    }
}
template <int DQK, int DV, bool BIAS, typename TQ, typename TK, typename TV>
__global__ void k_attn_naive(const TQ* Q, int qs, int qh, const TK* K, int ks, int kh, const TV* V, int vs, int vh, float* O, int os, int oh,
                             int nheads, int hdiv, const int* pos, const float* btab, int use_exp2) {
    __shared__ float sq[4][DQK];
    int w = threadIdx.x >> 6, lane = threadIdx.x & 63;
    int wave = blockIdx.x * 4 + w;
    int t = wave / nheads, h = wave % nheads;
    float* q = sq[w];
    for (int d = lane; d < DQK; d += 64) q[d] = ldf(Q, (size_t)t * qs + h * qh + d);
    __syncthreads();
    int nk = (t / 64 + 1) * 64;
    float m = -INFINITY, l = 0.f, o0 = 0.f, o1 = 0.f;
    int pt = BIAS ? pos[t] : 0;
    const float bsc = use_exp2 ? 1.0f : (1.0f / LOG2E);
    for (int k0 = 0; k0 < nk; k0 += 64) {
        int key = k0 + lane;
        size_t kb = (size_t)key * ks + h * kh;
        float s = 0.f;
#pragma unroll 8
        for (int d = 0; d < DQK; ++d) s += q[d] * ldf(K, kb + d);
        if (BIAS) { int rel = pos[key] - pt; rel = rel < -128 ? -128 : (rel > 128 ? 128 : rel); s += btab[(h / hdiv) * 257 + rel + 128] * bsc; }
        float mn = fmaxf(m, wave_max(s));
        float p = use_exp2 ? exp2f(s - mn) : expf(s - mn), corr = use_exp2 ? exp2f(m - mn) : expf(m - mn);
        l = l * corr + wave_sum(p); o0 *= corr; o1 *= corr;
#pragma unroll 8
        for (int j = 0; j < 64; ++j) {
            float pj = __shfl(p, j);
            size_t vb = (size_t)(k0 + j) * vs + (h / hdiv) * vh;
            o0 += pj * ldf(V, vb + lane);
            if (DV == 128) o1 += pj * ldf(V, vb + 64 + lane);
        }
        m = mn;
    }
    float* orow = O + (size_t)t * os + h * oh;
    orow[lane] = o0 / l;
    if (DV == 128) orow[64 + lane] = o1 / l;
}
__global__ void k_diff_combine(const float* tmpO, const float* scal, const float* subln_g, float* Ocat) {
    int wave = blockIdx.x * 4 + (threadIdx.x >> 6), lane = threadIdx.x & 63;
    int t = wave >> 2, h = wave & 3;
    float lam = scal[0];
    const float* a0 = tmpO + (size_t)t * 1024 + (h * 2) * 128;
    const float* a1 = a0 + 128;
    float v0 = a0[lane] - lam * a1[lane], v1 = a0[64 + lane] - lam * a1[64 + lane];
    float ss = wave_sum(v0 * v0 + v1 * v1);
    float rs = rsqrtf(ss * (1.f / 128.f) + EPS);
    float* o = Ocat + (size_t)t * 1024 + 512 + h * 128;
    o[lane] = v0 * rs * subln_g[lane] * 0.8f; o[64 + lane] = v1 * rs * subln_g[64 + lane] * 0.8f;
}
__global__ void k_resid_norm2(const float* x, const float* ao, const float* g1, const float* g, const float* sh, const float* sc, float* x1, float* h2) {
    __shared__ float red[4];
    int r = blockIdx.x, tid = threadIdx.x;
    float4 xv = ((const float4*)(x + (size_t)r * 1024))[tid], av = ((const float4*)(ao + (size_t)r * 1024))[tid], gv = ((const float4*)g1)[tid];
    float4 v; v.x = xv.x + gv.x * av.x; v.y = xv.y + gv.y * av.y; v.z = xv.z + gv.z * av.z; v.w = xv.w + gv.w * av.w;
    ((float4*)(x1 + (size_t)r * 1024))[tid] = v;
    float ss = block_sum256(v.x * v.x + v.y * v.y + v.z * v.z + v.w * v.w, red);
    float rs = rsqrtf(ss * (1.f / 1024.f) + EPS);
    float4 gg = ((const float4*)g)[tid], s4 = ((const float4*)sh)[tid], c4 = ((const float4*)sc)[tid];
    float4 o; o.x = v.x * rs * gg.x * (1.f + c4.x) + s4.x; o.y = v.y * rs * gg.y * (1.f + c4.y) + s4.y;
    o.z = v.z * rs * gg.z * (1.f + c4.z) + s4.z; o.w = v.w * rs * gg.w * (1.f + c4.w) + s4.w;
    ((float4*)(h2 + (size_t)r * 1024))[tid] = o;
}
__global__ void k_norm2(const float* x1, const float* g, const float* sh, const float* sc, float* h2) {
    __shared__ float red[4];
    int r = blockIdx.x, tid = threadIdx.x;
    float4 v = ((const float4*)(x1 + (size_t)r * 1024))[tid];
    float ss = block_sum256(v.x * v.x + v.y * v.y + v.z * v.z + v.w * v.w, red);
    float rs = rsqrtf(ss * (1.f / 1024.f) + EPS);
    float4 gg = ((const float4*)g)[tid], s4 = ((const float4*)sh)[tid], c4 = ((const float4*)sc)[tid];
    float4 o; o.x = v.x * rs * gg.x * (1.f + c4.x) + s4.x; o.y = v.y * rs * gg.y * (1.f + c4.y) + s4.y;
    o.z = v.z * rs * gg.z * (1.f + c4.z) + s4.z; o.w = v.w * rs * gg.w * (1.f + c4.w) + s4.w;
    ((float4*)(h2 + (size_t)r * 1024))[tid] = o;
}
__global__ void k_moe_naive(const float* h2, float* out, const float* g2, const float* w_rg, const float* b_rg, const float* w_re, const float* b_re,
                            const float* w_gate, const float* w_up, const float* w_down) {
    __shared__ float st[1024];
    __shared__ float lg[20];
    __shared__ float he[512];
    __shared__ int sel[2];
    __shared__ float selw[2];
    int r = blockIdx.x, tid = threadIdx.x, w = tid >> 6, lane = tid & 63;
    ((float4*)st)[tid] = ((const float4*)(h2 + (size_t)r * 1024))[tid];
    __syncthreads();
    for (int o = w; o < 20; o += 4) {
        float a = 0.f;
        if (o < 4) { for (int k = lane; k < 1024; k += 64) a += st[k] * w_rg[k * 4 + o]; }
        else { for (int k = lane; k < 1024; k += 64) a += st[k] * w_re[k * 16 + (o - 4)]; }
        a = wave_sum(a);
        if (lane == 0) lg[o] = a + (o < 4 ? b_rg[o] : b_re[o - 4]);
    }
    __syncthreads();
    if (tid == 0) {
        int gi = 0; float gm = lg[0];
        for (int i = 1; i < 4; ++i) if (lg[i] > gm) { gm = lg[i]; gi = i; }
        float den = 0.f;
        for (int i = 0; i < 4; ++i) den += expf(lg[i] - gm);
        float gw = 1.f / den;
        const float* e = lg + 4 + gi * 4;
        int i1 = 0; float v1 = e[0];
        for (int i = 1; i < 4; ++i) if (e[i] > v1) { v1 = e[i]; i1 = i; }
        int i2 = -1; float v2 = -INFINITY;
        for (int i = 0; i < 4; ++i) if (i != i1 && e[i] > v2) { v2 = e[i]; i2 = i; }
        float e2 = expf(v2 - v1);
        sel[0] = gi * 4 + i1; sel[1] = gi * 4 + i2;
        selw[0] = gw / (1.f + e2); selw[1] = gw * e2 / (1.f + e2);
    }
    __syncthreads();
    float y0 = 0.f, y1 = 0.f, y2 = 0.f, y3 = 0.f;
    for (int j = 0; j < 2; ++j) {
        int e = sel[j]; float wgt = selw[j];
        const float* Wg = w_gate + (size_t)e * 1024 * 512;
        const float* Wu = w_up + (size_t)e * 1024 * 512;
        const float* Wd = w_down + (size_t)e * 512 * 1024;
        float ga0 = 0.f, ga1 = 0.f, up0 = 0.f, up1 = 0.f;
        for (int k = 0; k < 1024; ++k) {
            float s = st[k];
            ga0 += s * Wg[(size_t)k * 512 + tid]; ga1 += s * Wg[(size_t)k * 512 + 256 + tid];
            up0 += s * Wu[(size_t)k * 512 + tid]; up1 += s * Wu[(size_t)k * 512 + 256 + tid];
        }
        __syncthreads();
        he[tid] = ga0 / (1.f + expf(-ga0)) * up0; he[256 + tid] = ga1 / (1.f + expf(-ga1)) * up1;
        __syncthreads();
        float a0 = 0.f, a1 = 0.f, a2 = 0.f, a3 = 0.f;
        for (int k = 0; k < 512; ++k) {
            float s = he[k]; const float* wr = Wd + (size_t)k * 1024;
            a0 += s * wr[tid]; a1 += s * wr[256 + tid]; a2 += s * wr[512 + tid]; a3 += s * wr[768 + tid];
        }
        y0 += wgt * a0; y1 += wgt * a1; y2 += wgt * a2; y3 += wgt * a3;
    }
    float* o = out + (size_t)r * 1024;
    o[tid] += g2[tid] * y0; o[256 + tid] += g2[256 + tid] * y1; o[512 + tid] += g2[512 + tid] * y2; o[768 + tid] += g2[768 + tid] * y3;
}
}

extern "C" void kernel_launch(void* const* d_in, const int* in_sizes, int n_in, void* d_out, int out_size, void* d_ws, size_t ws_size, hipStream_t stream) {
    static int grid = 0;
    if (grid == 0) {
        int dev = 0, cus = 0, per_cu = 0;
        if (n_in != 30 || ws_size < WS_END) { fprintf(stderr, "kernel_launch: unexpected inputs (n_in %d, ws %zu)\n", n_in, ws_size); grid = -1; return; }
        if (hipGetDevice(&dev) != hipSuccess || hipDeviceGetAttribute(&cus, hipDeviceAttributeMultiprocessorCount, dev) != hipSuccess) { grid = -1; return; }
        if (hipFuncSetAttribute((const void*)mk_fwd, hipFuncAttributeMaxDynamicSharedMemorySize, LDS_BYTES) != hipSuccess) { fprintf(stderr, "kernel_launch: hipFuncSetAttribute failed\n"); grid = -1; return; }
        if (hipOccupancyMaxActiveBlocksPerMultiprocessor(&per_cu, (const void*)mk_fwd, NWAVES * 64, LDS_BYTES) != hipSuccess || per_cu < 1) { fprintf(stderr, "kernel_launch: occupancy query says %d\n", per_cu); }
        (void)hipGetLastError();
        grid = cus;
    }
    if (grid < 0) return;
    hipMemsetAsync((char*)d_ws + WS_CTL, 0, CTL_ZERO_BYTES, stream);
    Args a{};
    for (int i = 0; i < 30; ++i) a.in[i] = (const float*)d_in[i];
    a.positions = (const int*)d_in[2]; a.out = (float*)d_out; a.ws = (unsigned char*)d_ws;
#ifdef DBG_MKPH
    a.ph_lo = 0; a.ph_hi = DBG_MKPH;
#else
    a.ph_lo = 0; a.ph_hi = N_PHASES;
#endif
    hipLaunchKernelGGL(mk_fwd, dim3(grid), dim3(NWAVES * 64), LDS_BYTES, stream, a);

#if STEP <= 5 || defined(DBG_MKPH)
    unsigned char* ws = (unsigned char*)d_ws;
    const float* x = (const float*)d_in[0];
    const int* positions = (const int*)d_in[2];
    const float* mod = (const float*)(ws + WS_MOD);
    const float* scal = (const float*)(ws + WS_SCAL);
    const float* btab = scal + 64;
    const float* cs = (const float*)(ws + WS_CS);
    const bf16* proj = (const bf16*)(ws + WS_PROJ);
    float* out = (float*)d_out;
#if STEP == 1
    float* r2 = (float*)(ws + 165 * MiB); float* r1 = (float*)(ws + 13 * MiB);
    float* kv_raw = r2; r2 += (size_t)S * 1024;
    float* q_raw = r2; r2 += (size_t)S * 768;
    float* Qm = r2; r2 += (size_t)S * 768;
    float* Km = r2; r2 += (size_t)S * 768;
    float* Qd = r2; r2 += (size_t)S * 512;
    float* Kd = r2; r2 += (size_t)S * 512;
    float* cqn = r2; r2 += (size_t)S * 384;
    float* ckvn = r2; r2 += (size_t)S * 256;
    float* tmpO = r1; r1 += (size_t)S * 1024;
    float* Ocat = r1; r1 += (size_t)S * 1024;
    float* ao = tmpO; float* h2 = Qm;
#elif STEP <= 3
    float* r1 = (float*)(ws + 13 * MiB);
    float* Qm = r1; r1 += (size_t)S * 768;
    float* Km = r1; r1 += (size_t)S * 768;
    float* Qd = r1; r1 += (size_t)S * 512;
    float* Kd = r1; r1 += (size_t)S * 512;
    float* tmpO = r1; r1 += (size_t)S * 1024;
    float* Ocat = r1; r1 += (size_t)S * 1024;
    const bf16* qraw_all = (const bf16*)(ws + WS_QRAW); const bf16* kvraw_all = (const bf16*)(ws + WS_KVRAW); const bf16* km_all = (const bf16*)(ws + WS_KM);
    float* ao = tmpO; float* h2 = Qm;
#else
    float* r1 = (float*)(ws + (STEP >= 6 ? 197 : 13) * MiB);
    float* ao = r1; r1 += (size_t)(STEP >= 6 ? 0 : S) * 1024;
    float* h2 = r1; r1 += (size_t)S * 1024;
    const bf16* ocat_all = (const bf16*)(ws + WS_HA); (void)ocat_all; (void)ao;
#endif
    for (int b = 0; b < NB; ++b) {
        const float* xb = x + (size_t)b * S * 1024;
        float* ob = out + (size_t)b * S * 1024;
        const float* mb = mod + b * 6144;
        const int* pb = positions + b * S;
        const float* csb = cs + (size_t)b * S * 32;
        const bf16* pj = proj + (size_t)b * S * PW;
        (void)pb; (void)csb; (void)pj; (void)btab; (void)scal;
#if STEP == 1
        nv::k_rms_seg<bf16><<<S / 4, 256, 0, stream>>>(pj, PW, P_CQ, 384, (const float*)d_in[8], cqn);
        nv::k_rms_seg<bf16><<<S / 4, 256, 0, stream>>>(pj, PW, P_CKV, 256, (const float*)d_in[10], ckvn);
        nv::k_gemm<float><<<dim3(768 / 64, S / 64), 256, 0, stream>>>(cqn, 384, (const float*)d_in[9], 768, q_raw, 768, S, 768, 384);
        nv::k_gemm<float><<<dim3(1024 / 64, S / 64), 256, 0, stream>>>(ckvn, 256, (const float*)d_in[11], 1024, kv_raw, 1024, S, 1024, 256);
        nv::k_prep_mla<float, float, bf16><<<S * 8 / 256, 256, 0, stream>>>(q_raw, 768, kv_raw, 1024, pj + P_KPE, PW, csb, (const float*)d_in[12], (const float*)d_in[13], Qm, Km);
        nv::k_prep_diff<bf16><<<S * 8 / 256, 256, 0, stream>>>(pj + P_DQ, pj + P_DK, PW, (const float*)d_in[14], (const float*)d_in[15], Qd, Kd);
        nv::k_attn_naive<96, 64, false, float, float, float><<<S * 8 / 4, 256, 0, stream>>>(Qm, 768, 96, Km, 768, 96, kv_raw + 64, 1024, 128, Ocat, 1024, 64, 8, 1, pb, btab, 0);
        nv::k_attn_naive<64, 128, true, float, float, bf16><<<S * 8 / 4, 256, 0, stream>>>(Qd, 512, 64, Kd, 512, 64, pj + P_DV, PW, 128, tmpO, 1024, 128, 8, 2, pb, btab, 0);
#elif STEP == 2
        const bf16* qr = qraw_all + (size_t)b * S * 768; const bf16* kvr = kvraw_all + (size_t)b * S * 1024;
        nv::k_prep_mla<bf16, bf16, bf16><<<S * 8 / 256, 256, 0, stream>>>(qr, 768, kvr, 1024, pj + P_KPE, PW, csb, (const float*)d_in[12], (const float*)d_in[13], Qm, Km);
        nv::k_prep_diff<bf16><<<S * 8 / 256, 256, 0, stream>>>(pj + P_DQ, pj + P_DK, PW, (const float*)d_in[14], (const float*)d_in[15], Qd, Kd);
        nv::k_attn_naive<96, 64, false, float, float, bf16><<<S * 8 / 4, 256, 0, stream>>>(Qm, 768, 96, Km, 768, 96, kvr + 64, 1024, 128, Ocat, 1024, 64, 8, 1, pb, btab, 0);
        nv::k_attn_naive<64, 128, true, float, float, bf16><<<S * 8 / 4, 256, 0, stream>>>(Qd, 512, 64, Kd, 512, 64, pj + P_DV, PW, 128, tmpO, 1024, 128, 8, 2, pb, btab, 0);
#elif STEP == 3
        const bf16* qr = qraw_all + (size_t)b * S * 768; const bf16* kvr = kvraw_all + (size_t)b * S * 1024; const bf16* kmr = km_all + (size_t)b * S * 768;
        nv::k_attn_naive<96, 64, false, bf16, bf16, bf16><<<S * 8 / 4, 256, 0, stream>>>(qr, 768, 96, kmr, 768, 96, kvr + 64, 1024, 128, Ocat, 1024, 64, 8, 1, pb, btab, 1);
        nv::k_attn_naive<64, 128, true, bf16, bf16, bf16><<<S * 8 / 4, 256, 0, stream>>>(pj + P_DQ, PW, 64, pj + P_DK, PW, 64, pj + P_DV, PW, 128, tmpO, 1024, 128, 8, 2, pb, btab, 1);
        (void)Km; (void)Qd; (void)Kd;
#endif
#if STEP >= 5
        nv::k_norm2<<<S, 256, 0, stream>>>(ob, (const float*)d_in[22], mb + 3072, mb + 4096, h2);
#elif STEP <= 3
        nv::k_diff_combine<<<S * 4 / 4, 256, 0, stream>>>(tmpO, scal, (const float*)d_in[20], Ocat);
        nv::k_gemm<float><<<dim3(1024 / 64, S / 64), 256, 0, stream>>>(Ocat, 1024, (const float*)d_in[21], 1024, ao, 1024, S, 1024, 1024);
#else
        nv::k_gemm<bf16><<<dim3(1024 / 64, S / 64), 256, 0, stream>>>(ocat_all + (size_t)b * S * 1024, 1024, (const float*)d_in[21], 1024, ao, 1024, S, 1024, 1024);
#endif
#if STEP < 5
        nv::k_resid_norm2<<<S, 256, 0, stream>>>(xb, ao, mb + 2048, (const float*)d_in[22], mb + 3072, mb + 4096, ob, h2);
#endif
        nv::k_moe_naive<<<S, 256, 0, stream>>>(h2, ob, mb + 5120, (const float*)d_in[23], (const float*)d_in[24], (const float*)d_in[25], (const float*)d_in[26],
                                                (const float*)d_in[27], (const float*)d_in[28], (const float*)d_in[29]);
    }
#endif
}
```

```cpp
#include <hip/hip_runtime.h>
#include <cstdio>
#include <cstdint>
#include <math.h>

#ifndef STEP
#define STEP 6
#endif

#define GAS __attribute__((address_space(1)))
#define LAS __attribute__((address_space(3)))
typedef unsigned short bf16;
typedef unsigned short bf16_t;
typedef short bf16x8 __attribute__((ext_vector_type(8)));
typedef float f32x4 __attribute__((ext_vector_type(4)));
typedef float f32x16 __attribute__((ext_vector_type(16)));
typedef unsigned u32x4 __attribute__((ext_vector_type(4)));
typedef unsigned u32x2 __attribute__((ext_vector_type(2)));
typedef GAS unsigned gu32;

constexpr int D = 1024, NB = 4, S = 4096, T = NB * S;
constexpr int PW = 2304;
constexpr int P_CQ = 0, P_CKV = 384, P_KPE = 640, P_DQ = 768, P_DK = 1280, P_DV = 1792;
constexpr float EPS = 1e-6f;
constexpr float LOG2E = 1.4426950408889634f;

constexpr size_t MiB = 1u << 20;
constexpr size_t WS_CTL = 0, CTL_ZERO_BYTES = 256 * 1024;
constexpr size_t WS_MOD = 1 * MiB;
constexpr size_t WS_SCAL = 1 * MiB + 128 * 1024;
constexpr size_t WS_CS = 2 * MiB;
constexpr size_t WS_WIN = 4 * MiB;
constexpr size_t WS_WUQ = 9 * MiB;
constexpr size_t WS_WUKV = 10 * MiB;
constexpr size_t WS_WO = 11 * MiB;
constexpr size_t WS_WGU = 13 * MiB;
constexpr size_t WS_WD = 45 * MiB;
constexpr size_t WS_HA = 61 * MiB;
constexpr size_t WS_PROJ = 93 * MiB;
constexpr size_t WS_QRAW = 165 * MiB;
constexpr size_t WS_KVRAW = 189 * MiB;
constexpr size_t WS_KM = 221 * MiB;
constexpr size_t WS_H2 = 165 * MiB;
constexpr size_t WS_HB = 93 * MiB;
constexpr size_t WS_LIST = 245 * MiB;
constexpr size_t WS_WL = 247 * MiB;
constexpr size_t WS_END = 256 * MiB;
constexpr int CW_TMO = 0, CW_QUEUE = 1024  , CW_BCNT = 1280  , CW_BAR = 4096  ;

constexpr int RING_BYTES = 131072;
constexpr int RS_OFF = RING_BYTES;
constexpr int LDSCTL_OFF = RS_OFF + 2048;
constexpr int LDS_BYTES = 147456;
constexpr int NWAVES = 8;

#define LDS_WAIT() asm volatile("s_waitcnt lgkmcnt(0)" ::: "memory")
#define VM_WAIT() asm volatile("s_waitcnt vmcnt(0)" ::: "memory")
__device__ __forceinline__ unsigned f2bf(float f) { unsigned u = __builtin_bit_cast(unsigned, f); return (u + 0x7fffu + ((u >> 16) & 1u)) >> 16; }
__device__ __forceinline__ unsigned pk2(float lo, float hi) { return f2bf(lo) | (f2bf(hi) << 16); }
__device__ __forceinline__ float bf2f(unsigned short v) { return __builtin_bit_cast(float, (unsigned)v << 16); }
__device__ __forceinline__ float wave_sum(float v) {
#pragma unroll
    for (int o = 1; o < 64; o <<= 1) v += __shfl_xor(v, o);
    return v;
}
__device__ __forceinline__ float wave_max(float v) {
#pragma unroll
    for (int o = 1; o < 64; o <<= 1) v = fmaxf(v, __shfl_xor(v, o));
    return v;
}

#define XB_TMO      128
#define XB_XCNT(j)  (256  + 64 * (j))
#define XB_XSUB(j)  (1280 + 64 * (j))
#define XB_XGEN(j)  (2304 + 64 * (j))
#define XB_TOP      3328
#define XB_TOPGEN   3392
#define XCD_BAR_WORDS 3456
#define XB_SPIN_CAP (1u << 18)
__device__ __forceinline__ unsigned xb_ld(unsigned* p)              { return __hip_atomic_load(p, __ATOMIC_RELAXED, __HIP_MEMORY_SCOPE_AGENT); }
__device__ __forceinline__ unsigned xb_add(unsigned* p, unsigned v) { return __hip_atomic_fetch_add(p, v, __ATOMIC_RELAXED, __HIP_MEMORY_SCOPE_AGENT); }
__device__ __forceinline__ unsigned xb_xcc_id() { return (unsigned)__builtin_amdgcn_s_getreg((3 << 11) | 20) & 0xFu; }
#define XB_SPIN(cond, bar) do { unsigned _sp = 0; while (cond) { __builtin_amdgcn_s_sleep(1); \
    if ((++_sp & 255u) == 0u) { if (xb_ld(&(bar)[XB_TMO])) break; if (_sp > XB_SPIN_CAP) { atomicAdd(&(bar)[XB_TMO], 1u); break; } } } } while (0)
struct XcdBarrier { unsigned* bar; unsigned x; volatile LAS unsigned* st; };
__device__ __forceinline__ XcdBarrier xcd_barrier_post(unsigned* bar, volatile LAS unsigned* st) {
    XcdBarrier b; b.bar = bar; b.x = xb_xcc_id(); b.st = st;
    if (threadIdx.x == 0) (void)xb_add(&bar[XB_XCNT(b.x)], 1u);
    return b;
}
__device__ __forceinline__ void xcd_barrier_complete(unsigned* bar, unsigned x, unsigned& nloc, unsigned& nx) {
    const unsigned G = gridDim.x * gridDim.y * gridDim.z;
    unsigned sum, cnt, mine, sp = 0u;
    for (;;) {
        sum = 0u; cnt = 0u; mine = 0u;
#pragma unroll
        for (unsigned j = 0; j < 16; ++j) { const unsigned c = xb_ld(&bar[XB_XCNT(j)]); sum += c; cnt += (c > 0u) ? 1u : 0u; mine = (j == x) ? c : mine; }
        if (sum == G) break;
        __builtin_amdgcn_s_sleep(1);
        if ((++sp & 255u) == 0u) { if (xb_ld(&bar[XB_TMO])) break; if (sp > XB_SPIN_CAP) { atomicAdd(&bar[XB_TMO], 1u); break; } }
    }
    nloc = mine > 0u ? mine : 1u; nx = cnt > 0u ? cnt : 1u;
}
__device__ __forceinline__ void xcd_barrier(const XcdBarrier& b) {
    asm volatile("s_waitcnt vmcnt(0)" ::: "memory");
    __syncthreads();
    if (threadIdx.x == 0) {
        unsigned* bar = b.bar;
        __builtin_amdgcn_s_waitcnt(0);
        unsigned nloc = b.st[0], nx = b.st[1];
        if (nloc == 0u) { xcd_barrier_complete(bar, b.x, nloc, nx); b.st[0] = nloc; b.st[1] = nx; }
        const unsigned old = xb_add(&bar[XB_XSUB(b.x)], 1u);
        const unsigned gen = old / nloc;
        if (old + 1u == (gen + 1u) * nloc) {
            __builtin_amdgcn_fence(__ATOMIC_RELEASE, "agent");
            asm volatile("s_waitcnt vmcnt(0)" ::: "memory");
            const unsigned og = xb_add(&bar[XB_TOP], 1u);
            const unsigned tg = og / nx;
            if (og + 1u == (tg + 1u) * nx) xb_add(&bar[XB_TOPGEN], 1u);
            else XB_SPIN(xb_ld(&bar[XB_TOPGEN]) == tg, bar);
            __builtin_amdgcn_fence(__ATOMIC_ACQUIRE, "agent");
            xb_add(&bar[XB_XGEN(b.x)], 1u);
            asm volatile("s_waitcnt vmcnt(0)" ::: "memory");
        } else {
            XB_SPIN(xb_ld(&bar[XB_XGEN(b.x)]) == gen, bar);
            __builtin_amdgcn_fence(__ATOMIC_ACQUIRE, "agent");
            asm volatile("s_waitcnt vmcnt(0)" ::: "memory");
        }
    }
    __syncthreads();
}

namespace pg8 {
constexpr int BM = 256, BK = 64, HALF = 128, HTB = HALF * BK * 2, STAGE_BYTES = 8 * HTB, NXCD = 8, WGM = 8;
__host__ __device__ __forceinline__ int lds_byte(int r, int c) { const int st = (r >> 4) * 2 + (c >> 5), rr = r & 15, cc = c & 31, ob = rr * 64 + cc * 2; return st * 1024 + (ob ^ (((ob >> 9) & 1) << 5)); }
__host__ __device__ __forceinline__ void stage_rc(int b, int& R, int& C) { const int st = b / 1024, sb = b % 1024, swz = sb ^ (((sb >> 9) & 1) << 5); R = (st >> 1) * 16 + swz / 64; C = (st & 1) * 32 + (swz % 64) / 2; }
__host__ __device__ __forceinline__ int perm32(int rho) { const int n = rho >> 4, i = rho & 15; return 8 * (i >> 2) + 4 * n + (i & 3); }

struct Unit { int pm, pn, aux; };

struct DenseSched {
    int nM, nN, nwg, G, c; const char* Bt; unsigned lda_b, ldb_b;
    __device__ void init(int M, int N, int G_, int c_, const void* Bt_, int lda, int ldb) { nM = M / BM; nN = N / BM; nwg = nM * nN; G = G_; c = c_; Bt = (const char*)Bt_; lda_b = (unsigned)lda * 2u; ldb_b = (unsigned)ldb * 2u; }
    __device__ __forceinline__ bool next(int i, Unit& u) const {
        const long L = (long)i * G + c; if (L >= nwg) return false;
        int wgid = (int)L; { const int q = nwg / NXCD, r = nwg % NXCD, xcd = wgid % NXCD, off = wgid / NXCD; wgid = (xcd < r ? xcd * (q + 1) : r * (q + 1) + (xcd - r) * q) + off; }
        const int nig = WGM * nN, gid = wgid / nig, fm = gid * WGM, gsz = (nM - fm) < WGM ? (nM - fm) : WGM;
        u.pm = fm + ((wgid % nig) % gsz); u.pn = (wgid % nig) / gsz; u.aux = 0; return true;
    }
    __device__ __forceinline__ unsigned a_row_off(const Unit& u, int row) const { return (unsigned)(u.pm * BM + row) * lda_b; }
    __device__ __forceinline__ const char* b_tile(const Unit& u, int kt) const { return Bt + (size_t)u.pn * BM * ldb_b + (size_t)kt * (BK * 2); }
};

__device__ __forceinline__ unsigned cvt_pk_bf16(float lo, float hi) { unsigned r; asm volatile("v_cvt_pk_bf16_f32 %0, %1, %2" : "=v"(r) : "v"(lo), "v"(hi)); return r; }

struct EpiStoreBf16 {
    static constexpr bool PERM = true;
    bf16_t* O; int ldc; bool use_rs;
    __device__ __forceinline__ void prep(const Unit&, int, LAS unsigned char*) const {}
    __device__ __forceinline__ void operator()(const f32x4 (&acc)[2][2][4][2], const Unit& u, int ui, int wr, int wc, int fr, int fq, LAS unsigned char* lds) const {
        const int row0 = u.pm * BM + wr * 64 + fr, col0 = u.pn * BM + wc * 32 + 8 * fq;
#pragma unroll
        for (int ai = 0; ai < 2; ++ai)
#pragma unroll
            for (int m = 0; m < 4; ++m) { bf16_t* rowp = O + (size_t)(row0 + ai * HALF + m * 16) * ldc + col0;
#pragma unroll
                for (int bj = 0; bj < 2; ++bj) { const f32x4 v0 = acc[ai][bj][m][0], v1 = acc[ai][bj][m][1];
                    u32x4 w; w.x = cvt_pk_bf16(v0[0], v0[1]); w.y = cvt_pk_bf16(v0[2], v0[3]); w.z = cvt_pk_bf16(v1[0], v1[1]); w.w = cvt_pk_bf16(v1[2], v1[3]);
                    *(u32x4*)(rowp + bj * HALF) = w; } }
    }
};

struct EpiStoreBf16RS {
    static constexpr bool PERM = true;
    bf16_t* O; int ldc; const bf16_t* A; int lda; int K;
    __device__ __forceinline__ void prep(const Unit& u, int ui, LAS unsigned char* lds) const {
        LAS float* tab = (LAS float*)(lds + RS_OFF) + (ui & 1) * 256;
        const int tid = threadIdx.x, wid = tid >> 6, lane = tid & 63;
        const float invK = 1.0f / (float)K;
#pragma unroll 1
        for (int i = 0; i < 4; ++i) {
            const int row = wid * 32 + i * 8 + (lane >> 3);
            const bf16_t* p = A + (size_t)(u.pm * BM + row) * lda + (lane & 7) * 8;
            float ss = 0.f;
            for (int j = 0; j < K / 64; ++j) { const u32x4 v = *(const u32x4*)(p + 64 * j);
#pragma unroll
                for (int e = 0; e < 4; ++e) { const float lo = __builtin_bit_cast(float, v[e] << 16), hi = __builtin_bit_cast(float, v[e] & 0xffff0000u); ss += lo * lo + hi * hi; } }
            ss += __shfl_xor(ss, 1); ss += __shfl_xor(ss, 2); ss += __shfl_xor(ss, 4);
            if ((lane & 7) == 0) tab[row] = rsqrtf(ss * invK + EPS);
        }
    }
    __device__ __forceinline__ void operator()(const f32x4 (&acc)[2][2][4][2], const Unit& u, int ui, int wr, int wc, int fr, int fq, LAS unsigned char* lds) const {
        const LAS float* tab = (const LAS float*)(lds + RS_OFF) + (ui & 1) * 256;
        const int row0 = u.pm * BM + wr * 64 + fr, col0 = u.pn * BM + wc * 32 + 8 * fq;
#pragma unroll
        for (int ai = 0; ai < 2; ++ai)
#pragma unroll
            for (int m = 0; m < 4; ++m) { bf16_t* rowp = O + (size_t)(row0 + ai * HALF + m * 16) * ldc + col0; const float rs = tab[ai * HALF + wr * 64 + m * 16 + fr];
#pragma unroll
                for (int bj = 0; bj < 2; ++bj) { const f32x4 v0 = acc[ai][bj][m][0] * rs, v1 = acc[ai][bj][m][1] * rs;
                    u32x4 w; w.x = cvt_pk_bf16(v0[0], v0[1]); w.y = cvt_pk_bf16(v0[2], v0[3]); w.z = cvt_pk_bf16(v1[0], v1[1]); w.w = cvt_pk_bf16(v1[2], v1[3]);
                    *(u32x4*)(rowp + bj * HALF) = w; } }
    }
};

struct EpiResid {
    static constexpr bool PERM = false;
    const float* x; float* out; const float* mod;
    __device__ __forceinline__ void prep(const Unit&, int, LAS unsigned char*) const {}
    __device__ __forceinline__ void operator()(const f32x4 (&acc)[2][2][4][2], const Unit& u, int ui, int wr, int wc, int fr, int fq, LAS unsigned char* lds) const {
        const int b = (u.pm * BM) / S; const int col0 = u.pn * BM + wc * 32 + 4 * fq;
        f32x4 gv[2][2];
#pragma unroll
        for (int bj = 0; bj < 2; ++bj)
#pragma unroll
            for (int n = 0; n < 2; ++n) gv[bj][n] = *(const f32x4*)(mod + b * 6144 + 2048 + col0 + bj * HALF + n * 16);
#pragma unroll
        for (int ai = 0; ai < 2; ++ai)
#pragma unroll
            for (int m = 0; m < 4; ++m) { const size_t off = (size_t)(u.pm * BM + ai * HALF + wr * 64 + m * 16 + fr) * 1024 + col0;
#pragma unroll
                for (int bj = 0; bj < 2; ++bj)
#pragma unroll
                    for (int n = 0; n < 2; ++n) { const f32x4 xv = *(const f32x4*)(x + off + bj * HALF + n * 16); *(f32x4*)(out + off + bj * HALF + n * 16) = xv + gv[bj][n] * acc[ai][bj][m][n]; } }
    }
};

constexpr int MOE_TAB_OFF = LDSCTL_OFF + 128;
__device__ __forceinline__ void moe_pair(int bk, int& elo, int& ehi) { const int gi = bk / 6, ix = bk % 6; const int a = ix < 3 ? 0 : (ix < 5 ? 1 : 2); const int b2 = ix < 3 ? ix + 1 : (ix < 5 ? ix - 1 : 3); elo = gi * 4 + a; ehi = gi * 4 + b2; }
struct MoeSched {
    int G, c, npn, ntiles; const LAS int* tab; const int* list; const char* W; unsigned a_pitch; bool gather; bool down;
    __device__ __forceinline__ bool next(int i, Unit& u) const {
        const int L = i * G + c; if (L >= ntiles * npn) return false;
        u.pm = L / npn; u.pn = L % npn; int bk = 0;
#pragma unroll 1
        for (int k = 1; k < 24; ++k) if (tab[k] <= u.pm) bk = k;
        u.aux = bk; return true;
    }
    __device__ __forceinline__ unsigned a_row_off(const Unit& u, int row) const {
        if (!gather) return (unsigned)(u.pm * BM + row) * a_pitch;
        const int bk = u.aux, r = (u.pm - tab[bk]) * BM + row, n = tab[32 + bk];
        int tok = list[bk * 16384 + (r < n ? r : 0)]; tok = tok < 0 ? 0 : (tok > T - 1 ? T - 1 : tok);
        return (unsigned)tok * a_pitch;
    }
    __device__ __forceinline__ const char* b_tile(const Unit& u, int kt) const {
        int elo, ehi; moe_pair(u.aux, elo, ehi);
        if (!down) { const int e = u.pn < 4 ? elo : ehi; return W + ((size_t)(e * 4 + (u.pn & 3)) * 256) * 2048 + (size_t)kt * 128; }
        const int e = kt < 8 ? elo : ehi;
        return W + ((size_t)e * 1024 + u.pn * 256) * 1024 + (size_t)(kt & 7) * 128;
    }
};
struct EpiSwiglu {
    static constexpr bool PERM = true;
    bf16_t* H; const float* wl; const LAS int* tab;
    __device__ __forceinline__ void prep(const Unit&, int, LAS unsigned char*) const {}
    __device__ __forceinline__ void operator()(const f32x4 (&acc)[2][2][4][2], const Unit& u, int ui, int wr, int wc, int fr, int fq, LAS unsigned char* lds) const {
        const int bk = u.aux, n = tab[32 + bk], r0 = (u.pm - tab[bk]) * BM; const int col0 = u.pn * 128 + wc * 32 + 8 * fq; const int which = u.pn < 4 ? 0 : 1;
#pragma unroll
        for (int ai = 0; ai < 2; ++ai)
#pragma unroll
            for (int m = 0; m < 4; ++m) { const int row = ai * HALF + wr * 64 + m * 16 + fr; const int r = r0 + row;
                const float w = r < n ? wl[((size_t)bk * 16384 + r) * 2 + which] : 0.f;
                float hv[8];
#pragma unroll
                for (int nn = 0; nn < 2; ++nn)
#pragma unroll
                    for (int e = 0; e < 4; ++e) { const float g = acc[ai][0][m][nn][e], up = acc[ai][1][m][nn][e]; hv[nn * 4 + e] = g * __builtin_amdgcn_rcpf(1.f + __builtin_amdgcn_exp2f(-g * LOG2E)) * up * w; }
                u32x4 o; o.x = cvt_pk_bf16(hv[0], hv[1]); o.y = cvt_pk_bf16(hv[2], hv[3]); o.z = cvt_pk_bf16(hv[4], hv[5]); o.w = cvt_pk_bf16(hv[6], hv[7]);
                *(u32x4*)(H + (size_t)(u.pm * BM + row) * 1024 + col0) = o; }
    }
};
struct EpiMoeOut {
    static constexpr bool PERM = false;
    float* out; const float* mod; const int* list; const LAS int* tab;
    __device__ __forceinline__ void prep(const Unit&, int, LAS unsigned char*) const {}
    __device__ __forceinline__ void operator()(const f32x4 (&acc)[2][2][4][2], const Unit& u, int ui, int wr, int wc, int fr, int fq, LAS unsigned char* lds) const {
        const int bk = u.aux, n = tab[32 + bk], r0 = (u.pm - tab[bk]) * BM; const int col0 = u.pn * BM + wc * 32 + 4 * fq;
#pragma unroll
        for (int ai = 0; ai < 2; ++ai)
#pragma unroll
            for (int m = 0; m < 4; ++m) { const int r = r0 + ai * HALF + wr * 64 + m * 16 + fr;
                if (r < n) { const int tok = list[bk * 16384 + r]; const int b = tok / S; float* op = out + (size_t)tok * 1024 + col0; const float* gp = mod + b * 6144 + 5120 + col0;
#pragma unroll
                    for (int bj = 0; bj < 2; ++bj)
#pragma unroll
                        for (int nn = 0; nn < 2; ++nn) { const f32x4 xv = *(const f32x4*)(op + bj * HALF + nn * 16), gv = *(const f32x4*)(gp + bj * HALF + nn * 16); *(f32x4*)(op + bj * HALF + nn * 16) = xv + gv * acc[ai][bj][m][nn]; } } }
    }
};

template <class Epi, class Sched, bool ALIGN_EPI>
__device__ __forceinline__ void gemm_phase(LAS unsigned char* lds, const char* Abase, int ldb, int K, const Sched& S, const Epi& E) {
    const int tid = threadIdx.x, wid = __builtin_amdgcn_readfirstlane(tid >> 6), lane = tid & 63, wr = wid >> 2, wc = wid & 3, fr = lane & 15, fq = lane >> 4;
    const int nt = K / BK;
    int RA[2], CA[2]; unsigned voffB[2];
#pragma unroll
    for (int i = 0; i < 2; ++i) { int R, C; stage_rc(tid * 16 + i * 8192, R, C); const int Rb = Epi::PERM ? ((R & ~31) + perm32(R & 31)) : R;
        RA[i] = R; CA[i] = C * 2; voffB[i] = (unsigned)(Rb * ldb + C) * 2u; }
    const size_t hstepB = (size_t)HALF * ldb * 2;
    const unsigned ldsw = (unsigned)wid * 1024u;
    const int aoff = lds_byte(wr * 64 + fr, fq * 8), boff = lds_byte(wc * 32 + fr, fq * 8);
#define PG8_SA(b, h) (((b) * 2 + (h)) * HTB)
#define PG8_SB(b, h) ((4 + (b) * 2 + (h)) * HTB)
#define PG8_GLDS(gp, bufoff, i) __builtin_amdgcn_global_load_lds((const unsigned*)(gp), (LAS unsigned*)(lds + (bufoff) + ldsw + (i) * 8192), 16, 0, 0)
#define PG8_STAGE_A(bufoff, VO, h, kt) do { _Pragma("unroll") for (int _i = 0; _i < 2; ++_i) PG8_GLDS(Abase + (VO)[h][_i] + (size_t)(kt) * (BK * 2), bufoff, _i); } while (0)
#define PG8_STAGE_B(bufoff, bp, h) do { _Pragma("unroll") for (int _i = 0; _i < 2; ++_i) PG8_GLDS((bp) + (h) * hstepB + voffB[_i], bufoff, _i); } while (0)
#define PG8_LDA(dst, b, h) do { _Pragma("unroll") for (int m = 0; m < 4; ++m) _Pragma("unroll") for (int k = 0; k < 2; ++k) dst[m][k] = *(const LAS bf16x8*)(lds + PG8_SA(b, h) + aoff + m * 2048 + k * 1024); } while (0)
#define PG8_LDB(dst, b, h) do { _Pragma("unroll") for (int n = 0; n < 2; ++n) _Pragma("unroll") for (int k = 0; k < 2; ++k) dst[n][k] = *(const LAS bf16x8*)(lds + PG8_SB(b, h) + boff + n * 2048 + k * 1024); } while (0)
#define PG8_MMA(ai, bj, At, Bt) do { __builtin_amdgcn_s_setprio(1); _Pragma("unroll") for (int m = 0; m < 4; ++m) _Pragma("unroll") for (int n = 0; n < 2; ++n) _Pragma("unroll") for (int k = 0; k < 2; ++k) \
        acc[ai][bj][m][n] = __builtin_amdgcn_mfma_f32_16x16x32_bf16(Bt[n][k], At[m][k], acc[ai][bj][m][n], 0, 0, 0); __builtin_amdgcn_s_setprio(0); } while (0)
#define PG8_WAIT_V(n) asm volatile("s_waitcnt vmcnt(" #n ")" ::: "memory")
#define PG8_WAIT_L(n) asm volatile("s_waitcnt lgkmcnt(" #n ")" ::: "memory")
#define PG8_BAR __builtin_amdgcn_s_barrier()
#define PG8_SCHED __builtin_amdgcn_sched_barrier(0)
#define PG8_VOFF(VO, U) do { _Pragma("unroll") for (int _h = 0; _h < 2; ++_h) _Pragma("unroll") for (int _i = 0; _i < 2; ++_i) (VO)[_h][_i] = S.a_row_off(U, _h * HALF + RA[_i]) + (unsigned)CA[_i]; } while (0)
    Unit cur, nxt; int ui = 0;
    if (!S.next(0, cur)) return;
    f32x4 acc[2][2][4][2];
#pragma unroll
    for (int a = 0; a < 2; ++a)
#pragma unroll
        for (int b = 0; b < 2; ++b)
#pragma unroll
            for (int m = 0; m < 4; ++m)
#pragma unroll
                for (int n = 0; n < 2; ++n) acc[a][b][m][n] = (f32x4){0.f, 0.f, 0.f, 0.f};
    bf16x8 At[4][2], B0[2][2], B1[2][2];
    unsigned voA[2][2], voN[2][2];
    PG8_VOFF(voA, cur);
    E.prep(cur, 0, lds);
    {
        const char* b0 = S.b_tile(cur, 0); const char* b1 = S.b_tile(cur, 1);
        PG8_STAGE_B(PG8_SB(0, 0), b0, 0); PG8_STAGE_B(PG8_SB(0, 1), b0, 1); PG8_STAGE_A(PG8_SA(0, 0), voA, 0, 0); PG8_STAGE_A(PG8_SA(0, 1), voA, 1, 0);
        if (wr == 1) PG8_BAR;
        PG8_WAIT_V(2); PG8_BAR;
        PG8_STAGE_B(PG8_SB(1, 0), b1, 0); PG8_STAGE_A(PG8_SA(1, 0), voA, 0, 1); PG8_STAGE_B(PG8_SB(1, 1), b1, 1);
        PG8_WAIT_V(6); PG8_BAR;
    }
    for (;;) {
        const bool has_next = S.next(ui + 1, nxt);
        if (has_next) { PG8_VOFF(voN, nxt); E.prep(nxt, ui + 1, lds); }
        else {
#pragma unroll
            for (int _h = 0; _h < 2; ++_h)
#pragma unroll
                for (int _i = 0; _i < 2; ++_i) voN[_h][_i] = voA[_h][_i];
            nxt = cur; }
        for (int t = 0; t < nt; t += 2) {
            const bool last = (t == nt - 2);
            unsigned vo2[2][2];
#pragma unroll
            for (int _h = 0; _h < 2; ++_h)
#pragma unroll
                for (int _i = 0; _i < 2; ++_i) vo2[_h][_i] = last ? voN[_h][_i] : voA[_h][_i];
            const int kt2 = last ? 0 : t + 2, kt3 = kt2 + 1;
            const char* b2 = last ? S.b_tile(nxt, 0) : S.b_tile(cur, t + 2);
            const char* b3 = last ? S.b_tile(nxt, 1) : S.b_tile(cur, t + 3);
            PG8_LDB(B0, 0, 0); PG8_LDB(B1, 0, 1); PG8_SCHED; PG8_LDA(At, 0, 0); PG8_STAGE_A(PG8_SA(1, 1), voA, 1, t + 1);
            PG8_WAIT_V(8); PG8_WAIT_L(0); PG8_BAR; PG8_MMA(0, 0, At, B0); PG8_MMA(0, 1, At, B1); PG8_BAR; PG8_SCHED;
            PG8_LDA(At, 0, 1); PG8_STAGE_B(PG8_SB(0, 0), b2, 0); PG8_STAGE_B(PG8_SB(0, 1), b2, 1); PG8_STAGE_A(PG8_SA(0, 0), vo2, 0, kt2);
            PG8_WAIT_V(8); PG8_WAIT_L(0); PG8_BAR; PG8_MMA(1, 0, At, B0); PG8_MMA(1, 1, At, B1); PG8_BAR; PG8_SCHED;
            PG8_LDB(B0, 1, 0); PG8_LDB(B1, 1, 1); PG8_SCHED; PG8_LDA(At, 1, 0); PG8_STAGE_A(PG8_SA(0, 1), vo2, 1, kt2);
            PG8_WAIT_V(8); PG8_WAIT_L(0); PG8_BAR; PG8_MMA(0, 0, At, B0); PG8_MMA(0, 1, At, B1); PG8_BAR; PG8_SCHED;
            PG8_LDA(At, 1, 1); PG8_STAGE_B(PG8_SB(1, 0), b3, 0); PG8_STAGE_B(PG8_SB(1, 1), b3, 1); PG8_STAGE_A(PG8_SA(1, 0), vo2, 0, kt3);
            PG8_WAIT_V(8); PG8_WAIT_L(0); PG8_BAR; PG8_MMA(1, 0, At, B0); PG8_MMA(1, 1, At, B1); PG8_BAR; PG8_SCHED;
        }
        if constexpr (ALIGN_EPI) { if (wr == 0) PG8_BAR; }
        E(acc, cur, ui, wr, wc, fr, fq, lds);
        if (!has_next) break;
#pragma unroll
        for (int a = 0; a < 2; ++a)
#pragma unroll
            for (int b = 0; b < 2; ++b)
#pragma unroll
                for (int m = 0; m < 4; ++m)
#pragma unroll
                    for (int n = 0; n < 2; ++n) acc[a][b][m][n] = (f32x4){0.f, 0.f, 0.f, 0.f};
        cur = nxt; ++ui;
#pragma unroll
        for (int _h = 0; _h < 2; ++_h)
#pragma unroll
            for (int _i = 0; _i < 2; ++_i) voA[_h][_i] = voN[_h][_i];
        if constexpr (ALIGN_EPI) { if (wr == 1) PG8_BAR; }
    }
    PG8_WAIT_V(0);
    if constexpr (!ALIGN_EPI) { if (wr == 0) PG8_BAR; }
    PG8_BAR;
#undef PG8_SA
#undef PG8_SB
#undef PG8_GLDS
#undef PG8_STAGE_A
#undef PG8_STAGE_B
#undef PG8_LDA
#undef PG8_LDB
#undef PG8_MMA
#undef PG8_WAIT_V
#undef PG8_WAIT_L
#undef PG8_BAR
#undef PG8_SCHED
#undef PG8_VOFF
}
}

struct Args {
    const float* in[30]; const int* positions; float* out; unsigned char* ws; int ph_lo, ph_hi, dup, li;
};
struct Frame {
    LAS unsigned char* lds; volatile LAS unsigned* MISC; gu32* ctl;
    int tid, lane, wave, wg, G;
};

__device__ __forceinline__ void tr_item(const float* src, int ldsrc, int k0, int n0, const float* gk, bf16* dst, int ldd, LAS float* scr, int lane) {
#pragma unroll 8
    for (int i = 0; i < 32; ++i) { const int kk = 2 * i + (lane >> 5); float v = src[(size_t)(k0 + kk) * ldsrc + n0 + (lane & 31)]; if (gk) v *= gk[k0 + kk]; scr[kk * 33 + (lane & 31)] = v; }
    LDS_WAIT(); asm volatile("" ::: "memory");
    const int c = lane & 7;
#pragma unroll
    for (int j = 0; j < 4; ++j) { const int n = (lane >> 3) + 8 * j; const LAS float* s = scr + (8 * c) * 33 + n;
        u32x4 o; o.x = pk2(s[0 * 33], s[1 * 33]); o.y = pk2(s[2 * 33], s[3 * 33]); o.z = pk2(s[4 * 33], s[5 * 33]); o.w = pk2(s[6 * 33], s[7 * 33]);
        *(GAS u32x4*)(dst + (size_t)n * ldd + k0 + 8 * c) = o; }
    LDS_WAIT(); asm volatile("" ::: "memory");
}

__device__ __forceinline__ void p0_prologue(Frame& F, const Args& a) {
    unsigned char* ws = a.ws;
    const float* c_in = a.in[1]; const float* rel_bias = a.in[3]; const float* w_ada = a.in[4]; const float* b_ada = a.in[5];
    float* mod = (float*)(ws + WS_MOD); float* scal = (float*)(ws + WS_SCAL); float* btab = scal + 64; int* tilemax = (int*)(scal + 64 + 1088);
    {
        LAS float* sc = (LAS float*)F.lds;
        LAS float* red = (LAS float*)(F.lds + 16384);
        for (int i = F.tid; i < 4096; i += 512) { const float v = c_in[i]; sc[i] = v / (1.f + __expf(-v)); }
        __syncthreads();
        for (int cb = F.wg; cb < 256; cb += F.G) {
            if (F.tid < 384) {
                const int kg = F.tid / 24, col = F.tid % 24, j = cb * 24 + col;
                float a0 = 0.f, a1 = 0.f, a2 = 0.f, a3 = 0.f;
#pragma unroll 8
                for (int kk = 0; kk < 64; ++kk) { const int k = kg * 64 + kk; const float w = w_ada[(size_t)k * 6144 + j];
                    a0 += sc[k] * w; a1 += sc[1024 + k] * w; a2 += sc[2048 + k] * w; a3 += sc[3072 + k] * w; }
                LAS float* r = red + (kg * 24 + col) * 4; r[0] = a0; r[1] = a1; r[2] = a2; r[3] = a3;
            }
            __syncthreads();
            if (F.tid < 96) { const int col = F.tid >> 2, b = F.tid & 3, j = cb * 24 + col; float s = 0.f;
#pragma unroll
                for (int kg = 0; kg < 16; ++kg) s += red[(kg * 24 + col) * 4 + b];
                __hip_atomic_store(mod + b * 6144 + j, s + b_ada[j], __ATOMIC_RELAXED, __HIP_MEMORY_SCOPE_AGENT); }
            __syncthreads();
        }
    }
    if (F.wg == 0) {
        if (F.tid < 64) {
            const float s1 = wave_sum(a.in[16][F.tid] * a.in[17][F.tid]);
            const float s2 = wave_sum(a.in[18][F.tid] * a.in[19][F.tid]);
            if (F.tid == 0) scal[0] = expf(s1) - expf(s2) + 0.2f;
        }
        for (int i = F.tid; i < 4 * 257; i += 512) {
            const int h = i / 257, rel = (i % 257) - 128; const int n = rel < 0 ? -rel : rel; int bk;
            if (n < 8) bk = n; else { const int lg = 31 - __clz(n * n); bk = 8 + lg - 6; if (bk > 15) bk = 15; }
            if (rel > 0) bk += 16;
            btab[i] = (rel_bias[bk * 4 + h] - rel_bias[15 * 4 + h]) * LOG2E;
        }
    }
    if (F.wg == 1 % F.G) {
        for (int i = F.tid; i < 256; i += 512) { int mx = -2147483647 - 1; for (int k = 0; k < 64; ++k) { const int p = a.positions[i * 64 + k]; mx = p > mx ? p : mx; } tilemax[i] = mx; }
    }
    {
        float* cs = (float*)(ws + WS_CS);
        for (int idx = F.wg * 512 + F.tid; idx < T * 16; idx += F.G * 512) {
            const int t = idx >> 4, i = idx & 15;
            double f = (i & 3) == 0 ? 1.0 : (i & 3) == 1 ? 0.5623413251903491 : (i & 3) == 2 ? 0.31622776601683794 : 0.1778279410038923;
            const int q = i >> 2; f = q == 0 ? f : q == 1 ? f * 0.1 : q == 2 ? f * 0.01 : f * 0.001;
            const double ang = (double)a.positions[t] * f;
            const double k = rint(ang * 0.6366197723675814);
            double r = fma(-k, 1.5707963267948966, ang); r = fma(-k, 6.123233995736766e-17, r);
            const double r2 = r * r;
            const double sn = r * (1.0 + r2 * (-1.0 / 6 + r2 * (1.0 / 120 + r2 * (-1.0 / 5040 + r2 * (1.0 / 362880 + r2 * (-1.0 / 39916800 + r2 * (1.0 / 6227020800.0)))))));
            const double cn = 1.0 + r2 * (-0.5 + r2 * (1.0 / 24 + r2 * (-1.0 / 720 + r2 * (1.0 / 40320 + r2 * (-1.0 / 3628800 + r2 * (1.0 / 479001600.0 + r2 * (-1.0 / 87178291200.0)))))));
            const int qd = (int)((long long)k & 3);
            const double cv = qd == 0 ? cn : qd == 1 ? -sn : qd == 2 ? -cn : sn;
            const double sv = qd == 0 ? sn : qd == 1 ? cn : qd == 2 ? -sn : -cn;
            cs[(size_t)t * 32 + i] = (float)cv; cs[(size_t)t * 32 + 16 + i] = (float)sv;
        }
    }
    {
        u32x4* z = (u32x4*)(ws + WS_WIN + (size_t)672 * 1024 * 2);
        for (int i = F.wg * 512 + F.tid; i < 96 * 1024 * 2 / 16; i += F.G * 512) z[i] = (u32x4){0u, 0u, 0u, 0u};
    }
    __syncthreads();
    {
        LAS float* scr = (LAS float*)(F.lds + F.wave * 16384);
        const int gw = F.wg * NWAVES + F.wave, NGW = F.G * NWAVES;
        constexpr int I_IN = 16 * 69, I_UQ = 6 * 24, I_UKV = 4 * 32, I_O = 16 * 32;
#if STEP >= 6
        constexpr int I_G = 16 * 16 * 16, I_D = 16 * 8 * 32;
#else
        constexpr int I_G = 0, I_D = 0;
#endif
        constexpr int NITEMS = I_IN + I_UQ + I_UKV + I_O + 2 * I_G + I_D;
        for (int it = gw; it < NITEMS; it += NGW) {
            int r = it;
            if (r < I_IN) { const int kb = r / 69, nb = r % 69, n0 = nb * 32, dn = n0 < 672 ? n0 : n0 + 96;
                tr_item(a.in[7], 2208, kb * 64, n0, nullptr, (bf16*)(ws + WS_WIN) + (size_t)dn * 1024, 1024, scr, F.lane); continue; } r -= I_IN;
            if (r < I_UQ) { const int kb = r / 24, nb = r % 24;
                tr_item(a.in[9], 768, kb * 64, nb * 32, a.in[8], (bf16*)(ws + WS_WUQ) + (size_t)nb * 32 * 384, 384, scr, F.lane); continue; } r -= I_UQ;
            if (r < I_UKV) { const int kb = r / 32, nb = r % 32;
                tr_item(a.in[11], 1024, kb * 64, nb * 32, a.in[10], (bf16*)(ws + WS_WUKV) + (size_t)nb * 32 * 256, 256, scr, F.lane); continue; } r -= I_UKV;
            if (r < I_O) { const int kb = r / 32, nb = r % 32;
                tr_item(a.in[21], 1024, kb * 64, nb * 32, nullptr, (bf16*)(ws + WS_WO) + (size_t)nb * 32 * 1024, 1024, scr, F.lane); continue; } r -= I_O;
#if STEP >= 6
            if (r < 2 * I_G) { const int up = r >= I_G; if (up) r -= I_G; const int e = r / 256, kb = (r % 256) / 16, nb = r % 16, n0 = nb * 32;
                const float* src = (up ? a.in[28] : a.in[27]) + (size_t)e * 1024 * 512;
                bf16* dst = (bf16*)(ws + WS_WGU) + ((size_t)(e * 4 + (n0 >> 7)) * 256 + (up ? 128 : 0) + (n0 & 127)) * 1024;
                tr_item(src, 512, kb * 64, n0, nullptr, dst, 1024, scr, F.lane); continue; } r -= 2 * I_G;
            { const int e = r / 256, kb = (r % 256) / 32, nb = r % 32;
                tr_item(a.in[29] + (size_t)e * 512 * 1024, 1024, kb * 64, nb * 32, nullptr, (bf16*)(ws + WS_WD) + ((size_t)e * 1024 + nb * 32) * 512, 512, scr, F.lane); }
#endif
        }
    }
}

__device__ __forceinline__ void p1_norm1(Frame& F, const Args& a) {
    const float* x = a.in[0]; const float* g = a.in[6]; const float* mod = (const float*)(a.ws + WS_MOD); bf16* hA = (bf16*)(a.ws + WS_HA);
    const int gw = F.wg * NWAVES + F.wave, NGW = F.G * NWAVES;
    for (int blk = gw; blk < T / 8; blk += NGW) {
        const int b = (blk * 8) / S; const float* mb = mod + b * 6144;
        f32x4 gm[4], sh[4];
#pragma unroll
        for (int j = 0; j < 4; ++j) { const f32x4 gg = ((const f32x4*)g)[F.lane + 64 * j], sc = ((const f32x4*)(mb + 1024))[F.lane + 64 * j]; gm[j] = gg * (sc + 1.0f); sh[j] = ((const f32x4*)mb)[F.lane + 64 * j]; }
        for (int rr = 0; rr < 8; ++rr) {
            const size_t row = (size_t)blk * 8 + rr;
            const GAS f32x4* xr = (const GAS f32x4*)(x + row * D) + F.lane;
            f32x4 v[4]; float s = 0.f;
#pragma unroll
            for (int j = 0; j < 4; ++j) { v[j] = xr[64 * j]; s += (v[j].x * v[j].x + v[j].y * v[j].y) + (v[j].z * v[j].z + v[j].w * v[j].w); }
            const float rs = rsqrtf(wave_sum(s) * (1.f / D) + EPS);
            GAS unsigned long long* o8 = (GAS unsigned long long*)(hA + row * D) + F.lane;
#pragma unroll
            for (int j = 0; j < 4; ++j) { const f32x4 o = v[j] * rs * gm[j] + sh[j];
                o8[64 * j] = (unsigned long long)pk2(o.x, o.y) | ((unsigned long long)pk2(o.z, o.w) << 32); }
        }
    }
}

struct P3Tok { u32x4 qv, kv, dqv, dkv; unsigned q1, q2, k1, k2; float c0, c1, n0, n1; };
__device__ __forceinline__ void p3b_prep(Frame& F, const Args& a) {
    unsigned char* ws = a.ws;
    bf16* qraw = (bf16*)(ws + WS_QRAW); const bf16* kvraw = (const bf16*)(ws + WS_KVRAW); bf16* proj = (bf16*)(ws + WS_PROJ); bf16* KM = (bf16*)(ws + WS_KM);
    const float* cs = (const float*)(ws + WS_CS);
    const float* mq_g = a.in[12]; const float* mk_g = a.in[13]; const float* dq_g = a.in[14]; const float* dk_g = a.in[15];
    const int lane = F.lane, h = lane >> 3, s8 = lane & 7;
    const int gw = F.wg * NWAVES + F.wave, NGW = F.G * NWAVES;
    float gq[12], gk[12], gdq[8], gdk[8];
#pragma unroll
    for (int j = 0; j < 8; ++j) { gq[j] = mq_g[8 * s8 + j]; gk[j] = mk_g[8 * s8 + j]; gdq[j] = dq_g[8 * s8 + j]; gdk[j] = dk_g[8 * s8 + j]; }
    gq[8] = mq_g[64 + 2 * s8]; gq[9] = mq_g[65 + 2 * s8]; gq[10] = mq_g[80 + 2 * s8]; gq[11] = mq_g[81 + 2 * s8];
    gk[8] = mk_g[64 + 2 * s8]; gk[9] = mk_g[65 + 2 * s8]; gk[10] = mk_g[80 + 2 * s8]; gk[11] = mk_g[81 + 2 * s8];
    const float qsc = 0.10206207261596577f * LOG2E, dsc = 0.125f * LOG2E;
#define P3_UNPACK(x, v, r1, r2) do { _Pragma("unroll") for (int e = 0; e < 4; ++e) { x[2 * e] = __builtin_bit_cast(float, v[e] << 16); x[2 * e + 1] = __builtin_bit_cast(float, v[e] & 0xffff0000u); } \
        x[8] = __builtin_bit_cast(float, (r1) << 16); x[9] = __builtin_bit_cast(float, (r1) & 0xffff0000u); x[10] = __builtin_bit_cast(float, (r2) << 16); x[11] = __builtin_bit_cast(float, (r2) & 0xffff0000u); } while (0)
    for (int t0 = gw * 4; t0 < T; t0 += NGW * 4) {
        P3Tok k[4];
#pragma unroll
        for (int i = 0; i < 4; ++i) { const int t = t0 + i;
            const bf16* qp = qraw + (size_t)t * 768 + h * 96; const bf16* kp = kvraw + (size_t)t * 1024 + h * 128; const bf16* pp = proj + (size_t)t * PW;
            k[i].qv = *(const u32x4*)(qp + 8 * s8); k[i].q1 = *(const unsigned*)(qp + 64 + 2 * s8); k[i].q2 = *(const unsigned*)(qp + 80 + 2 * s8);
            k[i].kv = *(const u32x4*)(kp + 8 * s8); k[i].k1 = *(const unsigned*)(pp + P_KPE + 2 * s8); k[i].k2 = *(const unsigned*)(pp + P_KPE + 16 + 2 * s8);
            k[i].dqv = *(const u32x4*)(pp + P_DQ + lane * 8); k[i].dkv = *(const u32x4*)(pp + P_DK + lane * 8);
            const float* cr = cs + (size_t)t * 32 + 2 * s8; k[i].c0 = cr[0]; k[i].c1 = cr[1]; k[i].n0 = cr[16]; k[i].n1 = cr[17]; }
#pragma unroll
        for (int i = 0; i < 4; ++i) { const int t = t0 + i; const float c0 = k[i].c0, c1 = k[i].c1, n0 = k[i].n0, n1 = k[i].n1;
            {
                bf16* qp = qraw + (size_t)t * 768 + h * 96; float x[12]; P3_UNPACK(x, k[i].qv, k[i].q1, k[i].q2);
                float ss = 0.f;
#pragma unroll
                for (int j = 0; j < 12; ++j) ss += x[j] * x[j];
                ss += __shfl_xor(ss, 1); ss += __shfl_xor(ss, 2); ss += __shfl_xor(ss, 4);
                const float rs = rsqrtf(ss * (1.f / 96.f) + EPS) * qsc;
#pragma unroll
                for (int j = 0; j < 12; ++j) x[j] *= rs * gq[j];
                u32x4 o; o.x = pk2(x[0], x[1]); o.y = pk2(x[2], x[3]); o.z = pk2(x[4], x[5]); o.w = pk2(x[6], x[7]);
                *(u32x4*)(qp + 8 * s8) = o;
                *(unsigned*)(qp + 64 + 2 * s8) = pk2(x[8] * c0 - x[10] * n0, x[9] * c1 - x[11] * n1);
                *(unsigned*)(qp + 80 + 2 * s8) = pk2(x[10] * c0 + x[8] * n0, x[11] * c1 + x[9] * n1);
            }
            {
                float x[12]; P3_UNPACK(x, k[i].kv, k[i].k1, k[i].k2);
                float ss = 0.f;
#pragma unroll
                for (int j = 0; j < 12; ++j) ss += x[j] * x[j];
                ss += __shfl_xor(ss, 1); ss += __shfl_xor(ss, 2); ss += __shfl_xor(ss, 4);
                const float rs = rsqrtf(ss * (1.f / 96.f) + EPS);
#pragma unroll
                for (int j = 0; j < 12; ++j) x[j] *= rs * gk[j];
                bf16* op = KM + (size_t)t * 768 + h * 96;
                u32x4 o; o.x = pk2(x[0], x[1]); o.y = pk2(x[2], x[3]); o.z = pk2(x[4], x[5]); o.w = pk2(x[6], x[7]);
                *(u32x4*)(op + 8 * s8) = o;
                *(unsigned*)(op + 64 + 2 * s8) = pk2(x[8] * c0 - x[10] * n0, x[9] * c1 - x[11] * n1);
                *(unsigned*)(op + 80 + 2 * s8) = pk2(x[10] * c0 + x[8] * n0, x[11] * c1 + x[9] * n1);
            }
#pragma unroll
            for (int qk = 0; qk < 2; ++qk) {
                bf16* dp = proj + (size_t)t * PW + (qk == 0 ? P_DQ : P_DK) + lane * 8;
                const u32x4 v = qk == 0 ? k[i].dqv : k[i].dkv;
                float x[8];
#pragma unroll
                for (int e = 0; e < 4; ++e) { x[2 * e] = __builtin_bit_cast(float, v[e] << 16); x[2 * e + 1] = __builtin_bit_cast(float, v[e] & 0xffff0000u); }
                float ss = 0.f;
#pragma unroll
                for (int j = 0; j < 8; ++j) ss += x[j] * x[j];
                ss += __shfl_xor(ss, 1); ss += __shfl_xor(ss, 2); ss += __shfl_xor(ss, 4);
                const float rs = rsqrtf(ss * (1.f / 64.f) + EPS) * (qk == 0 ? dsc : 1.0f);
#pragma unroll
                for (int j = 0; j < 8; ++j) x[j] *= rs * (qk == 0 ? gdq[j] : gdk[j]);
                u32x4 o; o.x = pk2(x[0], x[1]); o.y = pk2(x[2], x[3]); o.z = pk2(x[4], x[5]); o.w = pk2(x[6], x[7]);
                *(u32x4*)dp = o;
            }
        }
    }
#undef P3_UNPACK
}

namespace att {
typedef short v4i16_t __attribute__((ext_vector_type(4)));
typedef float f32x2_t __attribute__((ext_vector_type(2))); typedef __bf16 bf16x2_t __attribute__((ext_vector_type(2)));
__device__ __forceinline__ unsigned cvtpk_s(float lo, float hi) { f32x2_t v = {lo, hi}; bf16x2_t b = __builtin_convertvector(v, bf16x2_t); return __builtin_bit_cast(unsigned, b); }
__device__ __forceinline__ bf16x8 vtr2(const LAS unsigned char* p, int off_hi) {
    const v4i16_t lo = __builtin_amdgcn_ds_read_tr16_b64_v4i16((LAS v4i16_t*)p);
    const v4i16_t hi = __builtin_amdgcn_ds_read_tr16_b64_v4i16((LAS v4i16_t*)(p + off_hi));
    return (bf16x8){lo[0], lo[1], lo[2], lo[3], hi[0], hi[1], hi[2], hi[3]};
}
constexpr float THR = 8.0f;
__device__ __forceinline__ float max3f(float a, float b, float c) { float r; asm("v_max3_f32 %0, %1, %2, %3" : "=v"(r) : "v"(a), "v"(b), "v"(c)); return r; }
__device__ __forceinline__ float max2f(float a, float b) { float r; asm("v_max_f32_e32 %0, %1, %2" : "=v"(r) : "v"(a), "v"(b)); return r; }
__device__ __forceinline__ float fadd_s(float a, float b) { float r; asm("v_add_f32_e32 %0, %1, %2" : "=v"(r) : "v"(a), "v"(b)); return r; }

template <bool DIFF>
__device__ __forceinline__ void attn_unit(LAS unsigned char* lds, const Args& a, int b, int h, int qt, float lam) {
    constexpr int DQK = DIFF ? 64 : 96, DV = DIFF ? 128 : 64, KW = DIFF ? 128 : 96;
    constexpr int KRS = KW * 2 + 16, VRS = DV * 2 + 64;
    constexpr int OFF_K = 0, OFF_V = 2 * 64 * KRS, OFF_KPOS = OFF_V + 2 * 64 * VRS, OFF_BT = OFF_KPOS + 512, OFF_WSF = OFF_BT + 1040;
    static_assert(OFF_WSF + 8 * 256 <= RING_BYTES, "attention LDS");
    constexpr int QROWS = DIFF ? 128 : 256, NKP = KW * 2 / 16, NVP = DV * 2 / 16, ND = DQK / 16, NBLK = DV / 32;
    const int tid = threadIdx.x, lane = tid & 63, wid = __builtin_amdgcn_readfirstlane(tid >> 6), r32 = lane & 31, hi = lane >> 5;
    const int wq = DIFF ? (wid & 3) : wid, msub = DIFF ? (wid >> 2) : 0;
    const int q0 = qt * QROWS, NT = (q0 + QROWS) / 64, cw = (q0 + 32 * wq) / 64;
    const size_t tok0 = (size_t)b * S;
    unsigned char* ws = a.ws;
    const bf16* Qg; const unsigned char* Kg; const unsigned char* Vg; size_t kpitch, vpitch; int qpitch;
    if (DIFF) { const bf16* proj = (const bf16*)(ws + WS_PROJ);
        Qg = proj + tok0 * PW + P_DQ + h * 128 + msub * 64; qpitch = PW;
        Kg = (const unsigned char*)(proj + tok0 * PW + P_DK + h * 128); kpitch = PW * 2;
        Vg = (const unsigned char*)(proj + tok0 * PW + P_DV + h * 128); vpitch = PW * 2;
    } else {
        Qg = (const bf16*)(ws + WS_QRAW) + tok0 * 768 + h * 96; qpitch = 768;
        Kg = (const unsigned char*)((const bf16*)(ws + WS_KM) + tok0 * 768 + h * 96); kpitch = 768 * 2;
        Vg = (const unsigned char*)((const bf16*)(ws + WS_KVRAW) + tok0 * 1024 + h * 128 + 64); vpitch = 1024 * 2;
    }
    const int kp0 = tid, kp1 = tid + 512; const bool k1on = kp1 < 64 * NKP;
    const int kr0 = kp0 / NKP, kc0 = kp0 % NKP, kr1 = k1on ? kp1 / NKP : 0, kc1 = k1on ? kp1 % NKP : 0;
    const int vp0 = tid, vp1 = tid + 512; const bool v1on = vp1 < 64 * NVP;
    const int vr0 = vp0 / NVP, vc0 = vp0 % NVP, vr1 = v1on ? vp1 / NVP : 0, vc1 = v1on ? vp1 % NVP : 0;
    const size_t kg0 = (size_t)kr0 * kpitch + kc0 * 16, kg1 = (size_t)kr1 * kpitch + kc1 * 16, vg0 = (size_t)vr0 * vpitch + vc0 * 16, vg1 = (size_t)vr1 * vpitch + vc1 * 16;
    const int kl0 = OFF_K + kr0 * KRS + kc0 * 16, kl1 = OFF_K + kr1 * KRS + kc1 * 16, vl0 = OFF_V + vr0 * VRS + vc0 * 16, vl1 = OFF_V + vr1 * VRS + vc1 * 16;
    u32x4 sk0 = {0u, 0u, 0u, 0u}, sk1 = {0u, 0u, 0u, 0u}, sv0 = {0u, 0u, 0u, 0u}, sv1 = {0u, 0u, 0u, 0u}; int skp = 0;
#define ATT_LOAD(t) do { const size_t ko_ = (size_t)(t) * 64 * kpitch, vo_ = (size_t)(t) * 64 * vpitch; \
        sk0 = *(const u32x4*)(Kg + ko_ + kg0); if (k1on) sk1 = *(const u32x4*)(Kg + ko_ + kg1); \
        sv0 = *(const u32x4*)(Vg + vo_ + vg0); if (v1on) sv1 = *(const u32x4*)(Vg + vo_ + vg1); \
        if (DIFF && tid < 64) skp = a.positions[tok0 + (size_t)(t) * 64 + tid]; } while (0)
#define ATT_WRITE(buf) do { *(LAS u32x4*)(lds + (buf) * 64 * KRS + kl0) = sk0; if (k1on) *(LAS u32x4*)(lds + (buf) * 64 * KRS + kl1) = sk1; \
        *(LAS u32x4*)(lds + (buf) * 64 * VRS + vl0) = sv0; if (v1on) *(LAS u32x4*)(lds + (buf) * 64 * VRS + vl1) = sv1; \
        if (DIFF && tid < 64) *(LAS int*)(lds + OFF_KPOS + (buf) * 256 + tid * 4) = skp; } while (0)
    ATT_LOAD(0);
    bf16x8 qf[ND];
    { const bf16* qrow = Qg + (size_t)(q0 + 32 * wq + r32) * qpitch + 8 * hi;
#pragma unroll
      for (int d0 = 0; d0 < ND; ++d0) qf[d0] = *(const bf16x8*)(qrow + 16 * d0); }
    int qp = 0, qmin = 0;
    if (DIFF) {
        qp = a.positions[tok0 + q0 + 32 * wq + r32];
        int mn = qp;
#pragma unroll
        for (int o = 1; o < 64; o <<= 1) { const int x = __shfl_xor(mn, o); mn = x < mn ? x : mn; }
        qmin = __builtin_amdgcn_readfirstlane(mn);
        const float* btab = (const float*)(ws + WS_SCAL) + 64 + h * 257;
        if (tid < 257) *(LAS float*)(lds + OFF_BT + tid * 4) = btab[tid];
    }
    __builtin_amdgcn_s_waitcnt(0x0F70);
    ATT_WRITE(0);
    __syncthreads();
    LAS float* wsf = (LAS float*)(lds + OFF_WSF + wid * 256);
    const int kfa = OFF_K + r32 * KRS + 16 * hi + msub * 128;
    const int vfa = OFF_V + (4 * hi + ((lane & 15) >> 2)) * VRS + (16 * ((lane >> 4) & 1) + 4 * (lane & 3)) * 2;
    f32x16 o[NBLK];
#pragma unroll
    for (int i = 0; i < NBLK; ++i)
#pragma unroll
        for (int r = 0; r < 16; ++r) o[i][r] = 0.f;
    f32x16 negm;
#pragma unroll
    for (int r = 0; r < 16; ++r) negm[r] = 0.f;
    float mhat = 0.f, lsum = 0.f;
    const int* tilemax = (const int*)((const float*)(ws + WS_SCAL) + 64 + 1088) + b * 64;
    for (int t = 0; t < NT; ++t) {
        const int buf = t & 1;
        if (t + 1 < NT) ATT_LOAD(t + 1);
        if (t <= cw) {
            const LAS unsigned char* kb = lds + buf * 64 * KRS + kfa;
            f32x16 p0, p1;
#pragma unroll
            for (int d0 = 0; d0 < ND; ++d0) {
                const bf16x8 k0 = *(const LAS bf16x8*)(kb + d0 * 32), k1 = *(const LAS bf16x8*)(kb + 32 * KRS + d0 * 32);
                if (d0 == 0) { p0 = __builtin_amdgcn_mfma_f32_32x32x16_bf16(k0, qf[0], negm, 0, 0, 0); p1 = __builtin_amdgcn_mfma_f32_32x32x16_bf16(k1, qf[0], negm, 0, 0, 0); }
                else { p0 = __builtin_amdgcn_mfma_f32_32x32x16_bf16(k0, qf[d0], p0, 0, 0, 0); p1 = __builtin_amdgcn_mfma_f32_32x32x16_bf16(k1, qf[d0], p1, 0, 0, 0); }
            }
            if (DIFF) {
                const int tmx = tilemax[t];
                if (tmx - qmin > -128) {
                    const LAS unsigned char* kpp = lds + OFF_KPOS + buf * 256 + 16 * hi;
                    const LAS float* bt = (const LAS float*)(lds + OFF_BT);
#pragma unroll
                    for (int g = 0; g < 4; ++g) {
                        const u32x4 ka = *(const LAS u32x4*)(kpp + g * 32), kb2 = *(const LAS u32x4*)(kpp + 128 + g * 32);
#pragma unroll
                        for (int j = 0; j < 4; ++j) {
                            int r0 = (int)ka[j] - qp; r0 = r0 < -128 ? -128 : (r0 > 128 ? 128 : r0);
                            int r1 = (int)kb2[j] - qp; r1 = r1 < -128 ? -128 : (r1 > 128 ? 128 : r1);
                            p0[4 * g + j] += bt[r0 + 128]; p1[4 * g + j] += bt[r1 + 128];
                        }
                    }
                }
            }
            asm volatile("s_nop 15\n\ts_nop 7" : "+v"(p0), "+v"(p1));
            float mx;
            { float ma = max3f(p0[0], p0[1], p1[0]), mb = max3f(p0[2], p0[3], p1[1]); ma = max3f(ma, p1[2], p1[3]);
#pragma unroll
              for (int r = 4; r < 16; r += 4) { ma = max3f(ma, p0[r], p0[r + 1]); mb = max3f(mb, p0[r + 2], p0[r + 3]); ma = max3f(ma, p1[r], p1[r + 1]); mb = max3f(mb, p1[r + 2], p1[r + 3]); }
              mx = max2f(ma, mb);
              const auto rr = __builtin_amdgcn_permlane32_swap(__float_as_uint(mx), __float_as_uint(mx), false, false);
              mx = max2f(__uint_as_float(rr[0]), __uint_as_float(rr[1])); }
            if (__any(mx > THR)) {
                const float dl = fmaxf(mx, 0.f);
                mhat += dl;
#pragma unroll
                for (int r = 0; r < 16; ++r) { p0[r] -= dl; p1[r] -= dl; negm[r] = -mhat; }
                const float f = __builtin_amdgcn_exp2f(-dl);
                lsum *= f;
                if (hi == 0) wsf[r32] = f;
                LDS_WAIT();
#pragma unroll
                for (int g = 0; g < 4; ++g) { const f32x4 f4 = *(const LAS f32x4*)(wsf + 8 * g + 4 * hi);
#pragma unroll
                    for (int i = 0; i < NBLK; ++i)
#pragma unroll
                        for (int j = 0; j < 4; ++j) o[i][4 * g + j] *= f4[j]; }
            }
            float sa = 0.f, sb = 0.f;
#pragma unroll
            for (int r = 0; r < 16; ++r) { p0[r] = __builtin_amdgcn_exp2f(p0[r]); p1[r] = __builtin_amdgcn_exp2f(p1[r]); sa = fadd_s(sa, p0[r]); sb = fadd_s(sb, p1[r]); }
            lsum += fadd_s(sa, sb);
            u32x4 pw[4];
#pragma unroll
            for (int e = 0; e < 4; ++e) { pw[0][e] = cvtpk_s(p0[2 * e], p0[2 * e + 1]); pw[1][e] = cvtpk_s(p0[8 + 2 * e], p0[9 + 2 * e]);
                                          pw[2][e] = cvtpk_s(p1[2 * e], p1[2 * e + 1]); pw[3][e] = cvtpk_s(p1[8 + 2 * e], p1[9 + 2 * e]); }
            const LAS unsigned char* vb = lds + buf * 64 * VRS + vfa;
#pragma unroll
            for (int i = 0; i < NBLK; ++i)
#pragma unroll
                for (int ks = 0; ks < 4; ++ks) {
                    const bf16x8 vf = vtr2(vb + ks * 16 * VRS + i * 64, 8 * VRS);
                    o[i] = __builtin_amdgcn_mfma_f32_32x32x16_bf16(__builtin_bit_cast(bf16x8, pw[ks]), vf, o[i], 0, 0, 0);
                }
        }
        if (t + 1 < NT) ATT_WRITE(buf ^ 1);
        __syncthreads();
    }
#undef ATT_LOAD
#undef ATT_WRITE
    { const auto rr = __builtin_amdgcn_permlane32_swap(__float_as_uint(lsum), __float_as_uint(lsum), false, false); lsum = __uint_as_float(rr[0]) + __uint_as_float(rr[1]); }
    if (hi == 0) wsf[r32] = 1.0f / lsum;
    LDS_WAIT();
#pragma unroll
    for (int g = 0; g < 4; ++g) { const f32x4 f4 = *(const LAS f32x4*)(wsf + 8 * g + 4 * hi);
#pragma unroll
        for (int i = 0; i < NBLK; ++i)
#pragma unroll
            for (int j = 0; j < 4; ++j) o[i][4 * g + j] *= f4[j]; }
    bf16* Ocat = (bf16*)(ws + WS_HA);
    if (!DIFF) {
        LAS bf16* stg = (LAS bf16*)(lds + wid * 4096);
#pragma unroll
        for (int r = 0; r < 16; ++r) { const int orow = (r & 3) + 8 * (r >> 2) + 4 * hi;
#pragma unroll
            for (int i = 0; i < NBLK; ++i) stg[orow * 64 + i * 32 + r32] = (bf16)f2bf(o[i][r]); }
        LDS_WAIT();
        bf16* Ow = Ocat + (tok0 + q0 + 32 * wid) * 1024 + h * 64;
#pragma unroll
        for (int i = 0; i < 4; ++i) { const int row = i * 8 + (lane >> 3), ch = lane & 7; const u32x4 v = *(const LAS u32x4*)(stg + row * 64 + ch * 8); *(u32x4*)(Ow + (size_t)row * 1024 + ch * 8) = v; }
    } else {
        LAS float* X = (LAS float*)lds;
        if (msub == 1) {
#pragma unroll
            for (int r = 0; r < 16; ++r) { const int orow = 32 * wq + (r & 3) + 8 * (r >> 2) + 4 * hi;
#pragma unroll
                for (int i = 0; i < NBLK; ++i) X[orow * 132 + i * 32 + r32] = lam * o[i][r]; }
        }
        __syncthreads();
        if (msub == 0) {
#pragma unroll
            for (int r = 0; r < 16; ++r) { const int orow = 32 * wq + (r & 3) + 8 * (r >> 2) + 4 * hi;
#pragma unroll
                for (int i = 0; i < NBLK; ++i) { const int ix = orow * 132 + i * 32 + r32; X[ix] = o[i][r] - X[ix]; } }
        }
        __syncthreads();
        const float* sg = a.in[20];
        const int row = tid >> 2, part = tid & 3;
        float v[32]; float ss = 0.f;
#pragma unroll
        for (int c4 = 0; c4 < 8; ++c4) { const f32x4 x4 = *(const LAS f32x4*)(X + row * 132 + part * 32 + c4 * 4); v[4 * c4] = x4[0]; v[4 * c4 + 1] = x4[1]; v[4 * c4 + 2] = x4[2]; v[4 * c4 + 3] = x4[3];
            ss += (x4[0] * x4[0] + x4[1] * x4[1]) + (x4[2] * x4[2] + x4[3] * x4[3]); }
        ss += __shfl_xor(ss, 1); ss += __shfl_xor(ss, 2);
        const float rs = rsqrtf(ss * (1.f / 128.f) + EPS) * 0.8f;
        bf16* Ow = Ocat + (tok0 + q0 + row) * 1024 + 512 + h * 128 + part * 32;
#pragma unroll
        for (int c8 = 0; c8 < 4; ++c8) { u32x4 w;
#pragma unroll
            for (int e = 0; e < 4; ++e) { const int c = c8 * 8 + 2 * e; w[e] = pk2(v[c] * rs * sg[part * 32 + c], v[c + 1] * rs * sg[part * 32 + c + 1]); }
            *(u32x4*)(Ow + c8 * 8) = w; }
    }
    __syncthreads();
}

__device__ __forceinline__ void attn_phase(Frame& F, const Args& a, int qoff = 0) {
    LAS int* slot = (LAS int*)(F.lds + LDSCTL_OFF + 64);
    const float lam = ((const float*)(a.ws + WS_SCAL))[0];
    for (;;) {
        if (F.tid == 0) *slot = (int)__hip_atomic_fetch_add((unsigned*)(F.ctl + CW_QUEUE + qoff), 1u, __ATOMIC_RELAXED, __HIP_MEMORY_SCOPE_AGENT);
        __syncthreads();
        const int i = __builtin_amdgcn_readfirstlane(*slot);
        __syncthreads();
        if (i >= 512) break;
        attn_unit<false>(F.lds, a, (i & 31) >> 3, i & 7, 15 - (i >> 5), lam);
    }
    for (;;) {
        if (F.tid == 0) *slot = (int)__hip_atomic_fetch_add((unsigned*)(F.ctl + CW_QUEUE + 64 + qoff), 1u, __ATOMIC_RELAXED, __HIP_MEMORY_SCOPE_AGENT);
        __syncthreads();
        const int i = __builtin_amdgcn_readfirstlane(*slot);
        __syncthreads();
        if (i >= 512) break;
        attn_unit<true>(F.lds, a, (i & 15) >> 2, i & 3, 31 - (i >> 4), lam);
    }
}
}

__device__ __forceinline__ void p6_norm2_route(Frame& F, const Args& a) {
    unsigned char* ws = a.ws;
    const float* x1 = a.out; const float* g = a.in[22]; const float* mod = (const float*)(ws + WS_MOD); bf16* H2 = (bf16*)(ws + WS_H2);
    const float* w_rg = a.in[23]; const float* b_rg = a.in[24]; const float* w_re = a.in[25]; const float* b_re = a.in[26];
    int* list = (int*)(ws + WS_LIST); float* wl = (float*)(ws + WS_WL);
    LAS float* WT = (LAS float*)F.lds;
    for (int i = F.tid; i < 1024; i += 512) { const f32x4 v = *(const f32x4*)(w_rg + i * 4); WT[i] = v.x; WT[1024 + i] = v.y; WT[2048 + i] = v.z; WT[3072 + i] = v.w; }
    for (int i = F.tid; i < 4096; i += 512) { const int k = i >> 2, q = i & 3; const f32x4 v = *(const f32x4*)(w_re + k * 16 + q * 4);
        WT[(4 + 4 * q) * 1024 + k] = v.x; WT[(5 + 4 * q) * 1024 + k] = v.y; WT[(6 + 4 * q) * 1024 + k] = v.z; WT[(7 + 4 * q) * 1024 + k] = v.w; }
    __syncthreads();
    const int gw = F.wg * NWAVES + F.wave, NGW = F.G * NWAVES;
    float bg[4];
#pragma unroll
    for (int i = 0; i < 4; ++i) bg[i] = b_rg[i];
    for (int blk = gw; blk < T / 8; blk += NGW) {
        const int b = (blk * 8) / S; const float* mb = mod + b * 6144;
        f32x4 gm[4], sh[4];
#pragma unroll
        for (int j = 0; j < 4; ++j) { const f32x4 gg = ((const f32x4*)g)[F.lane + 64 * j], sc = ((const f32x4*)(mb + 4096))[F.lane + 64 * j]; gm[j] = gg * (sc + 1.0f); sh[j] = ((const f32x4*)(mb + 3072))[F.lane + 64 * j]; }
        int mybk = 0; float mywlo = 0.f, mywhi = 0.f;
        f32x4 nx[2][4];
#pragma unroll
        for (int u = 0; u < 2; ++u) { const GAS f32x4* xr = (const GAS f32x4*)(x1 + (size_t)(blk * 8 + u) * D) + F.lane;
#pragma unroll
            for (int j = 0; j < 4; ++j) nx[u][j] = xr[64 * j]; }
#pragma unroll 1
        for (int pr = 0; pr < 4; ++pr) {
            f32x4 v[2][4];
#pragma unroll
            for (int u = 0; u < 2; ++u)
#pragma unroll
                for (int j = 0; j < 4; ++j) v[u][j] = nx[u][j];
            if (pr < 3) {
#pragma unroll
                for (int u = 0; u < 2; ++u) { const GAS f32x4* xr = (const GAS f32x4*)(x1 + (size_t)(blk * 8 + 2 * pr + 2 + u) * D) + F.lane;
#pragma unroll
                    for (int j = 0; j < 4; ++j) nx[u][j] = xr[64 * j]; }
            }
#pragma unroll
            for (int u = 0; u < 2; ++u) {
                const int t = blk * 8 + 2 * pr + u;
                float s = 0.f;
#pragma unroll
                for (int j = 0; j < 4; ++j) s += (v[u][j].x * v[u][j].x + v[u][j].y * v[u][j].y) + (v[u][j].z * v[u][j].z + v[u][j].w * v[u][j].w);
                const float rs = rsqrtf(wave_sum(s) * (1.f / D) + EPS);
                GAS unsigned long long* o8 = (GAS unsigned long long*)(H2 + (size_t)t * D) + F.lane;
#pragma unroll
                for (int j = 0; j < 4; ++j) { v[u][j] = v[u][j] * rs * gm[j] + sh[j];
                    o8[64 * j] = (unsigned long long)pk2(v[u][j].x, v[u][j].y) | ((unsigned long long)pk2(v[u][j].z, v[u][j].w) << 32); }
                float lg[4];
#pragma unroll
                for (int o = 0; o < 4; ++o) { float acc = 0.f;
#pragma unroll
                    for (int j = 0; j < 4; ++j) { const f32x4 w4 = *(const LAS f32x4*)(WT + o * 1024 + 4 * F.lane + 256 * j); acc += (v[u][j].x * w4.x + v[u][j].y * w4.y) + (v[u][j].z * w4.z + v[u][j].w * w4.w); }
                    lg[o] = wave_sum(acc) + bg[o]; }
                int gi = 0; float gmx = lg[0];
#pragma unroll
                for (int i = 1; i < 4; ++i) if (lg[i] > gmx) { gmx = lg[i]; gi = i; }
                gi = __builtin_amdgcn_readfirstlane(gi);
                float den = 0.f;
#pragma unroll
                for (int i = 0; i < 4; ++i) den += __expf(lg[i] - gmx);
                const float gwt = 1.f / den;
                float e[4];
#pragma unroll
                for (int i = 0; i < 4; ++i) { float acc = 0.f; const LAS float* wrow = WT + (4 + gi * 4 + i) * 1024 + 4 * F.lane;
#pragma unroll
                    for (int j = 0; j < 4; ++j) { const f32x4 w4 = *(const LAS f32x4*)(wrow + 256 * j); acc += (v[u][j].x * w4.x + v[u][j].y * w4.y) + (v[u][j].z * w4.z + v[u][j].w * w4.w); }
                    e[i] = wave_sum(acc) + b_re[gi * 4 + i]; }
                int i1 = 0; float v1 = e[0];
#pragma unroll
                for (int i = 1; i < 4; ++i) if (e[i] > v1) { v1 = e[i]; i1 = i; }
                int i2 = -1; float v2 = -INFINITY;
#pragma unroll
                for (int i = 0; i < 4; ++i) if (i != i1 && e[i] > v2) { v2 = e[i]; i2 = i; }
                const float e2 = __expf(v2 - v1);
                const float w1 = gwt / (1.f + e2), w2 = gwt * e2 / (1.f + e2);
                const int ea = i1 < i2 ? i1 : i2, eb = i1 < i2 ? i2 : i1;
                const float wlo = i1 < i2 ? w1 : w2, whi = i1 < i2 ? w2 : w1;
                const int bk = gi * 6 + (ea * (7 - ea)) / 2 + (eb - ea - 1);
                if (F.lane == 2 * pr + u) { mybk = bk; mywlo = wlo; mywhi = whi; }
            }
        }
        if (F.lane < 8) {
            const int t = blk * 8 + F.lane;
            const unsigned slot = __hip_atomic_fetch_add((unsigned*)(F.ctl + CW_BCNT + 64 * mybk), 1u, __ATOMIC_RELAXED, __HIP_MEMORY_SCOPE_AGENT);
            __hip_atomic_store(list + mybk * 16384 + slot, t, __ATOMIC_RELAXED, __HIP_MEMORY_SCOPE_AGENT);
            const unsigned long long wpair = (unsigned long long)__builtin_bit_cast(unsigned, mywlo) | ((unsigned long long)__builtin_bit_cast(unsigned, mywhi) << 32);
            __hip_atomic_store((unsigned long long*)wl + ((size_t)mybk * 16384 + slot), wpair, __ATOMIC_RELAXED, __HIP_MEMORY_SCOPE_AGENT);
        }
    }
}
__device__ __forceinline__ int moe_table(Frame& F) {
    LAS int* tab = (LAS int*)(F.lds + pg8::MOE_TAB_OFF);
    if (F.tid == 0) { int acc = 0;
        for (int k = 0; k < 24; ++k) { const int n = (int)__hip_atomic_load((unsigned*)(F.ctl + CW_BCNT + 64 * k), __ATOMIC_RELAXED, __HIP_MEMORY_SCOPE_AGENT); tab[k] = acc; tab[32 + k] = n; acc += (n + 255) >> 8; }
        tab[24] = acc; }
    __syncthreads();
    return tab[24];
}

__global__ void __launch_bounds__(NWAVES * 64, 2) mk_fwd(Args args) {
    extern __shared__ __attribute__((aligned(16))) unsigned char lds_raw[];
    Frame F;
    F.lds = (LAS unsigned char*)lds_raw;
    F.MISC = (volatile LAS unsigned*)(F.lds + LDSCTL_OFF);
    F.tid = threadIdx.x; F.lane = F.tid & 63; F.wave = __builtin_amdgcn_readfirstlane(F.tid >> 6);
    F.G = gridDim.x; F.wg = blockIdx.x;
    F.ctl = (gu32*)(args.ws + WS_CTL);
    for (int u = F.tid; u < (LDS_BYTES - LDSCTL_OFF) / 4; u += NWAVES * 64) ((LAS unsigned*)(F.lds + LDSCTL_OFF))[u] = 0u;
    __syncthreads();
    XcdBarrier bar = xcd_barrier_post((unsigned*)(F.ctl + CW_BAR) + args.li * XCD_BAR_WORDS, F.MISC + 8);
    const int lo = args.ph_lo, hi = args.ph_hi;
#define IN(k) (lo <= (k) && (k) < hi)
#define BOTH(k) (IN(k) && IN((k) + 1))
    if (IN(0)) { p0_prologue(F, args); if (BOTH(0)) xcd_barrier(bar); }
    if (IN(1)) { p1_norm1(F, args); if (BOTH(1)) xcd_barrier(bar); }
    if (IN(2)) {
        pg8::DenseSched Sd; Sd.init(T, PW, F.G, F.wg, args.ws + WS_WIN, 1024, 1024);
        pg8::EpiStoreBf16 E{(bf16*)(args.ws + WS_PROJ), PW, false};
        pg8::gemm_phase<pg8::EpiStoreBf16, pg8::DenseSched, true>(F.lds, (const char*)(args.ws + WS_HA), 1024, 1024, Sd, E);
        if (BOTH(2)) xcd_barrier(bar);
    }
#if STEP >= 2
    if (IN(3)) {
        {   pg8::DenseSched Sd; Sd.init(T, 768, F.G, F.wg, args.ws + WS_WUQ, PW, 384);
            pg8::EpiStoreBf16RS E{(bf16*)(args.ws + WS_QRAW), 768, (const bf16*)(args.ws + WS_PROJ) + P_CQ, PW, 384};
            pg8::gemm_phase<pg8::EpiStoreBf16RS, pg8::DenseSched, true>(F.lds, (const char*)((const bf16*)(args.ws + WS_PROJ) + P_CQ), 384, 384, Sd, E); }
        {   pg8::DenseSched Sd; Sd.init(T, 1024, F.G, F.wg, args.ws + WS_WUKV, PW, 256);
            pg8::EpiStoreBf16RS E{(bf16*)(args.ws + WS_KVRAW), 1024, (const bf16*)(args.ws + WS_PROJ) + P_CKV, PW, 256};
            pg8::gemm_phase<pg8::EpiStoreBf16RS, pg8::DenseSched, true>(F.lds, (const char*)((const bf16*)(args.ws + WS_PROJ) + P_CKV), 256, 256, Sd, E); }
        if (BOTH(3)) xcd_barrier(bar);
    }
#endif
#if STEP >= 3
    if (IN(4)) { p3b_prep(F, args); if (BOTH(4)) xcd_barrier(bar); }
#endif
#if STEP >= 4
    if (IN(5)) { att::attn_phase(F, args, args.dup); if (BOTH(5)) xcd_barrier(bar); }
#endif
#if STEP >= 5
    if (IN(6)) {
        pg8::DenseSched Sd; Sd.init(T, 1024, F.G, F.wg, args.ws + WS_WO, 1024, 1024);
        pg8::EpiResid E{args.in[0], args.out, (const float*)(args.ws + WS_MOD)};
        pg8::gemm_phase<pg8::EpiResid, pg8::DenseSched, true>(F.lds, (const char*)(args.ws + WS_HA), 1024, 1024, Sd, E);
        if (BOTH(6)) xcd_barrier(bar);
    }
#endif
#if STEP >= 6
    if (IN(7)) { p6_norm2_route(F, args); if (BOTH(7)) xcd_barrier(bar); }
    if (IN(8)) {
        const int ntiles = moe_table(F);
        const LAS int* tab = (const LAS int*)(F.lds + pg8::MOE_TAB_OFF);
        pg8::MoeSched Sm{F.G, F.wg, 8, ntiles, tab, (const int*)(args.ws + WS_LIST), (const char*)(args.ws + WS_WGU), 2048u, true, false};
        pg8::EpiSwiglu E{(bf16*)(args.ws + WS_HB), (const float*)(args.ws + WS_WL), tab};
        pg8::gemm_phase<pg8::EpiSwiglu, pg8::MoeSched, true>(F.lds, (const char*)(args.ws + WS_H2), 1024, 1024, Sm, E);
        if (BOTH(8)) xcd_barrier(bar);
    }
    if (IN(9)) {
        const int ntiles = moe_table(F);
        const LAS int* tab = (const LAS int*)(F.lds + pg8::MOE_TAB_OFF);
        pg8::MoeSched Sm{F.G, F.wg, 4, ntiles, tab, (const int*)(args.ws + WS_LIST), (const char*)(args.ws + WS_WD), 2048u, false, true};
        pg8::EpiMoeOut E{args.out, (const float*)(args.ws + WS_MOD), (const int*)(args.ws + WS_LIST), tab};
        pg8::gemm_phase<pg8::EpiMoeOut, pg8::MoeSched, true>(F.lds, (const char*)(args.ws + WS_HB), 512, 1024, Sm, E);
    }
#endif
#undef IN
#undef BOTH
}
#if STEP >= 6
constexpr int N_PHASES = 10;
#elif STEP >= 5
constexpr int N_PHASES = 7;
#elif STEP >= 4
constexpr int N_PHASES = 6;
#elif STEP >= 3
constexpr int N_PHASES = 5;
#elif STEP >= 2
constexpr int N_PHASES = 4;
#else
constexpr int N_PHASES = 3;
#endif

extern "C" void kernel_launch(void* const* d_in, const int* in_sizes, int n_in, void* d_out, int out_size, void* d_ws, size_t ws_size, hipStream_t stream) {
    static int grid = 0;
    if (grid == 0) {
        int dev = 0, cus = 0, per_cu = 0;
        if (n_in != 30 || ws_size < WS_END) { fprintf(stderr, "kernel_launch: unexpected inputs (n_in %d, ws %zu)\n", n_in, ws_size); grid = -1; return; }
        if (hipGetDevice(&dev) != hipSuccess || hipDeviceGetAttribute(&cus, hipDeviceAttributeMultiprocessorCount, dev) != hipSuccess) { grid = -1; return; }
        if (hipFuncSetAttribute((const void*)mk_fwd, hipFuncAttributeMaxDynamicSharedMemorySize, LDS_BYTES) != hipSuccess) { fprintf(stderr, "kernel_launch: hipFuncSetAttribute failed\n"); grid = -1; return; }
        if (hipOccupancyMaxActiveBlocksPerMultiprocessor(&per_cu, (const void*)mk_fwd, NWAVES * 64, LDS_BYTES) != hipSuccess || per_cu < 1) { fprintf(stderr, "kernel_launch: occupancy query says %d\n", per_cu); }
        (void)hipGetLastError();
        grid = cus;
    }
    if (grid < 0) return;
    hipMemsetAsync((char*)d_ws + WS_CTL, 0, CTL_ZERO_BYTES, stream);
    Args a{};
    for (int i = 0; i < 30; ++i) a.in[i] = (const float*)d_in[i];
    a.positions = (const int*)d_in[2]; a.out = (float*)d_out; a.ws = (unsigned char*)d_ws;
#ifdef DUP_PHASE
    a.ph_lo = 0; a.ph_hi = DUP_PHASE + 1; a.dup = 0;
    hipLaunchKernelGGL(mk_fwd, dim3(grid), dim3(NWAVES * 64), LDS_BYTES, stream, a);
    a.ph_lo = DUP_PHASE; a.ph_hi = DUP_PHASE + 1; a.dup = 128; a.li = 1;
    hipLaunchKernelGGL(mk_fwd, dim3(grid), dim3(NWAVES * 64), LDS_BYTES, stream, a);
    if (DUP_PHASE + 1 < N_PHASES) { a.ph_lo = DUP_PHASE + 1; a.ph_hi = N_PHASES; a.dup = 0; a.li = 2;
        hipLaunchKernelGGL(mk_fwd, dim3(grid), dim3(NWAVES * 64), LDS_BYTES, stream, a); }
#else
    a.ph_lo = 0; a.ph_hi = N_PHASES;
    hipLaunchKernelGGL(mk_fwd, dim3(grid), dim3(NWAVES * 64), LDS_BYTES, stream, a);
#endif

}
```
